# Optimizing an MI355X kernel written in HIP

```python
import math
import jax
import jax.numpy as jnp
from jax import lax
import numpy as np

D_MODEL = 1024
BATCH = 32
SEQ = 2048
DEPTH = 4

CTX_LEN = 256
GRID_W = 64
RMS_EPS = 1e-6
L2_EPS = 1e-6
ROPE_THETA = 10000.0
Q_BLOCK = 128

HEAD_DIM = 64
ATTN_SCALE = HEAD_DIM ** -0.5
DIFF_HEADS = 4
DIFF_V_DIM = 2 * HEAD_DIM
GQA_Q_HEADS = 8
GQA_KV_HEADS = 2
GQA_REP = GQA_Q_HEADS // GQA_KV_HEADS
DIFF_QK_W = DIFF_HEADS * 2 * HEAD_DIM
DIFF_V_W = DIFF_HEADS * DIFF_V_DIM
GQA_Q_W = GQA_Q_HEADS * HEAD_DIM
GQA_KV_W = GQA_KV_HEADS * HEAD_DIM
ATTN_SPLIT_IDX = (DIFF_QK_W, 2 * DIFF_QK_W, 2 * DIFF_QK_W + DIFF_V_W,
                  2 * DIFF_QK_W + DIFF_V_W + GQA_Q_W,
                  2 * DIFF_QK_W + DIFF_V_W + GQA_Q_W + GQA_KV_W)
ATTN_IN_W = 2 * DIFF_QK_W + DIFF_V_W + GQA_Q_W + 2 * GQA_KV_W
ATTN_OUT_W = DIFF_V_W + GQA_Q_W

GDN_HEADS = 8
GDN_HEAD_DIM = 128
GDN_W = GDN_HEADS * GDN_HEAD_DIM
GDN_CONV_K = 4
GDN_CONV_LEFT = 2
GDN_CHUNK = 64
GDN_IN_W = 4 * GDN_W + 4 * GDN_HEADS

FFN_HIDDEN = -(-8 * D_MODEL // (3 * 256)) * 256

kernel_name = "hybrid_diffgqa_gdeltanet_dit_prefix"


def rms_norm(x, g):
    xf = x.astype(jnp.float32)
    y = xf * lax.rsqrt(jnp.mean(xf * xf, axis=-1, keepdims=True) + RMS_EPS)
    return (y * g.astype(jnp.float32)).astype(x.dtype)


def l2_normalize(x):
    xf = x.astype(jnp.float32)
    return xf * lax.rsqrt(jnp.sum(xf * xf, axis=-1, keepdims=True) + L2_EPS)


def modulate(h, shift, scale):
    return h * (1.0 + scale) + shift


def axial_rope_tables(n_tokens, rows):
    row_ids = jnp.repeat(jnp.arange(rows, dtype=jnp.float32), GRID_W)[:n_tokens]
    col_ids = jnp.tile(jnp.arange(GRID_W, dtype=jnp.float32), rows)[:n_tokens]
    axis_dim = HEAD_DIM // 2
    inv_freq = ROPE_THETA ** (-jnp.arange(0, axis_dim, 2, dtype=jnp.float32) / axis_dim)
    ang_r = row_ids[:, None] * inv_freq
    ang_c = col_ids[:, None] * inv_freq
    ang = jnp.concatenate([ang_r, ang_r, ang_c, ang_c], axis=-1)
    return jnp.cos(ang), jnp.sin(ang)


def apply_axial_rope(x, cos, sin):
    shape = (1, cos.shape[0]) + (1,) * (x.ndim - 3) + (cos.shape[1],)
    cos = cos.reshape(shape).astype(x.dtype)
    sin = sin.reshape(shape).astype(x.dtype)
    x1, x2, x3, x4 = jnp.split(x, 4, axis=-1)
    rot = jnp.concatenate([-x2, x1, -x4, x3], axis=-1)
    return x * cos + rot * sin


def sweep_query_blocks(fn, *qs):
    B, L = qs[0].shape[:2]
    n_blk = L // Q_BLOCK
    blocks = tuple(jnp.swapaxes(q.reshape((B, n_blk, Q_BLOCK) + q.shape[2:]), 0, 1) for q in qs)
    out = lax.map(lambda blk: fn(*blk), blocks)
    return jnp.swapaxes(out, 0, 1).reshape((B, L) + out.shape[3:])


def attn_project(h, w_in, qk_g, rope):
    B, L, _ = h.shape
    p = h @ w_in
    dq, dk, dv, gq, gk, gv = jnp.split(p, ATTN_SPLIT_IDX, axis=-1)
    dq = dq.reshape(B, L, DIFF_HEADS, 2, HEAD_DIM)
    dk = dk.reshape(B, L, DIFF_HEADS, 2, HEAD_DIM)
    dv = dv.reshape(B, L, DIFF_HEADS, DIFF_V_DIM)
    gq = rms_norm(gq.reshape(B, L, GQA_KV_HEADS, GQA_REP, HEAD_DIM), qk_g[0])
    gk = rms_norm(gk.reshape(B, L, GQA_KV_HEADS, HEAD_DIM), qk_g[1])
    gv = gv.reshape(B, L, GQA_KV_HEADS, HEAD_DIM)
    if rope is not None:
        cos, sin = rope
        dq = apply_axial_rope(dq, cos, sin)
        dk = apply_axial_rope(dk, cos, sin)
        gq = apply_axial_rope(gq, cos, sin)
        gk = apply_axial_rope(gk, cos, sin)
    return dq, dk, dv, gq, gk, gv


def attend_heads(dq, gq, keys, lam, lam_init, subln_g):
    dk, dv, gk, gv = keys
    B, Q = dq.shape[:2]
    s = jnp.einsum('bqhmd,bthmd->bhmqt', dq, dk) * ATTN_SCALE
    p = jax.nn.softmax(s.astype(jnp.float32), axis=-1)
    a = (p[:, :, 0] - lam * p[:, :, 1]).astype(dv.dtype)
    d_out = jnp.einsum('bhqt,bthe->bqhe', a, dv)
    d_out = rms_norm(d_out, subln_g) * (1.0 - lam_init)
    s = jnp.einsum('bqgrd,btgd->bgrqt', gq, gk) * ATTN_SCALE
    p = jax.nn.softmax(s.astype(jnp.float32), axis=-1).astype(gv.dtype)
    g_out = jnp.einsum('bgrqt,btgd->bqgrd', p, gv)
    return jnp.concatenate([d_out.reshape(B, Q, DIFF_V_W), g_out.reshape(B, Q, GQA_Q_W)], axis=-1)


def even_mixer(h_lat, h_ctx, w_in, w_out, lam_vec, subln_g, qk_g, lam_init, rope, need_ctx):
    lv = lam_vec.astype(jnp.float32)
    lam = jnp.exp(jnp.sum(lv[0] * lv[1])) - jnp.exp(jnp.sum(lv[2] * lv[3])) + lam_init
    cq_d, ck_d, cv_d, cq_g, ck_g, cv_g = attn_project(h_ctx, w_in, qk_g, None)
    lq_d, lk_d, lv_d, lq_g, lk_g, lv_g = attn_project(h_lat, w_in, qk_g, rope)
    ctx_keys = (ck_d, cv_d, ck_g, cv_g)
    all_keys = tuple(jnp.concatenate([kc, kl], axis=1)
                     for kc, kl in zip(ctx_keys, (lk_d, lv_d, lk_g, lv_g)))
    o_lat = sweep_query_blocks(
        lambda dq, gq: attend_heads(dq, gq, all_keys, lam, lam_init, subln_g), lq_d, lq_g)
    y_lat = o_lat @ w_out
    y_ctx = None
    if need_ctx:
        y_ctx = attend_heads(cq_d, cq_g, ctx_keys, lam, lam_init, subln_g) @ w_out
    return y_lat, y_ctx


def short_conv(x, w):
    L = x.shape[1]
    xp = jnp.pad(x, ((0, 0), (GDN_CONV_LEFT, GDN_CONV_K - 1 - GDN_CONV_LEFT), (0, 0)))
    out = xp[:, 0:L] * w[0]
    for j in range(1, GDN_CONV_K):
        out = out + xp[:, j:j + L] * w[j]
    return out


def gdn_project(h, w_in, conv_w, a_log, dt_bias):
    B, L, _ = h.shape
    p = h @ w_in
    qkv, z, a, b = jnp.split(p, (3 * GDN_W, 4 * GDN_W, 4 * GDN_W + 2 * GDN_HEADS), axis=-1)
    qkv = jax.nn.silu(short_conv(qkv, conv_w))
    q, k, v = (t.reshape(B, L, GDN_HEADS, GDN_HEAD_DIM) for t in jnp.split(qkv, 3, axis=-1))
    q = l2_normalize(q) * (GDN_HEAD_DIM ** -0.5)
    k = l2_normalize(k)
    a = a.reshape(B, L, 2, GDN_HEADS).astype(jnp.float32)
    b = b.reshape(B, L, 2, GDN_HEADS).astype(jnp.float32)
    g = -jnp.exp(a_log.astype(jnp.float32)) * jax.nn.softplus(a + dt_bias.astype(jnp.float32))
    beta = jax.nn.sigmoid(b)
    return q, k, v, z.reshape(B, L, GDN_HEADS, GDN_HEAD_DIM), g, beta


def gated_delta_chunked(q, k, v, g, beta, state0):
    B, L, H, DK = q.shape
    DV = v.shape[-1]
    n = L // GDN_CHUNK
    f32 = jnp.float32

    def to_chunks(t):
        return jnp.transpose(t.astype(f32).reshape(B, n, GDN_CHUNK, H, t.shape[-1]), (1, 0, 3, 2, 4))

    qc, kc, vc = to_chunks(q), to_chunks(k), to_chunks(v)
    gc = jnp.transpose(g.astype(f32).reshape(B, n, GDN_CHUNK, H), (1, 0, 3, 2))
    bc = jnp.transpose(beta.astype(f32).reshape(B, n, GDN_CHUNK, H), (1, 0, 3, 2))
    gcum = jnp.cumsum(gc, axis=-1)
    tril = jnp.tril(jnp.ones((GDN_CHUNK, GDN_CHUNK), dtype=bool))
    strict = jnp.tril(jnp.ones((GDN_CHUNK, GDN_CHUNK), dtype=bool), -1)
    diff = gcum[..., :, None] - gcum[..., None, :]
    decay = jnp.where(tril, jnp.exp(jnp.where(tril, diff, 0.0)), 0.0)
    kb = kc * bc[..., None]
    vb = vc * bc[..., None]
    m = jnp.where(strict, jnp.einsum('nbhid,nbhjd->nbhij', kb, kc) * decay, 0.0)
    eye = jnp.eye(GDN_CHUNK, dtype=f32)
    tmat = lax.linalg.triangular_solve(eye + m, jnp.broadcast_to(eye, m.shape),
                                       left_side=True, lower=True, unit_diagonal=True)
    u = jnp.einsum('nbhij,nbhjd->nbhid', tmat, vb)
    w = jnp.einsum('nbhij,nbhjd->nbhid', tmat, kb * jnp.exp(gcum)[..., None])

    def step(S, xs):
        q_i, k_i, u_i, w_i, g_i, dec_i = xs
        attn = jnp.einsum('bhid,bhjd->bhij', q_i, k_i) * dec_i
        v_new = u_i - jnp.einsum('bhid,bhde->bhie', w_i, S)
        o = (jnp.einsum('bhid,bhde->bhie', q_i * jnp.exp(g_i)[..., None], S)
             + jnp.einsum('bhij,bhje->bhie', attn, v_new))
        g_last = g_i[..., -1]
        S = (S * jnp.exp(g_last)[..., None, None]
             + jnp.einsum('bhid,bhie->bhde', k_i * jnp.exp(g_last[..., None] - g_i)[..., None], v_new))
        return S, o

    S, o = lax.scan(step, state0.astype(f32), (qc, kc, u, w, gcum, decay))
    o = jnp.transpose(o, (1, 0, 3, 2, 4)).reshape(B, L, H, DV)
    return o.astype(v.dtype), S


def odd_mixer(h_lat, h_ctx, w_in, conv_w, a_log, dt_bias, norm_g, w_out, need_ctx):
    cq, ck, cv, cz, cg, cb = gdn_project(h_ctx, w_in, conv_w, a_log, dt_bias)
    lq, lk, lv, lz, lg, lb = gdn_project(h_lat, w_in, conv_w, a_log, dt_bias)
    B = h_lat.shape[0]
    s0 = jnp.zeros((B, GDN_HEADS, GDN_HEAD_DIM, GDN_HEAD_DIM), jnp.float32)
    flip = lambda t: jnp.flip(t, axis=1)
    o_cf, s_f = gated_delta_chunked(cq, ck, cv, cg[:, :, 0], cb[:, :, 0], s0)
    o_lf, _ = gated_delta_chunked(lq, lk, lv, lg[:, :, 0], lb[:, :, 0], s_f)
    o_cb, s_b = gated_delta_chunked(flip(cq), flip(ck), flip(cv), flip(cg[:, :, 1]), flip(cb[:, :, 1]), s0)
    o_lb, _ = gated_delta_chunked(flip(lq), flip(lk), flip(lv), flip(lg[:, :, 1]), flip(lb[:, :, 1]), s_b)

    def readout(o, z):
        o = rms_norm(o, norm_g) * jax.nn.silu(z)
        return o.reshape(o.shape[0], o.shape[1], GDN_W) @ w_out

    y_lat = readout(o_lf + flip(o_lb), lz)
    y_ctx = readout(o_cf + flip(o_cb), cz) if need_ctx else None
    return y_lat, y_ctx


def swiglu(h, w_gate_up, w_down):
    gate, up = jnp.split(h @ w_gate_up, 2, axis=-1)
    return (jax.nn.silu(gate) * up) @ w_down


def setup_inputs(seed: int = 0) -> dict:
    key = jax.random.key(seed)
    ks = jax.random.split(key, 20)
    f32 = jnp.float32
    n_even = (DEPTH + 1) // 2
    n_odd = DEPTH // 2

    def nrm(k, shape, scale):
        return jax.random.normal(k, shape, f32) * scale

    x = nrm(ks[0], (BATCH, SEQ, D_MODEL), 1.0)
    c = nrm(ks[1], (BATCH, D_MODEL), 1.0)
    ctx = nrm(ks[2], (BATCH, CTX_LEN, D_MODEL), 1.0)
    c_ctx = nrm(ks[3], (D_MODEL,), 1.0)
    ada_w = nrm(ks[4], (DEPTH, D_MODEL, 6 * D_MODEL), 0.5 * D_MODEL ** -0.5)
    ada_b = nrm(ks[5], (DEPTH, 6 * D_MODEL), 0.02)
    norm_g = 1.0 + nrm(ks[6], (DEPTH, 4, D_MODEL), 0.05)
    attn_w_in = nrm(ks[7], (n_even, D_MODEL, ATTN_IN_W), D_MODEL ** -0.5)
    attn_w_out = nrm(ks[8], (n_even, ATTN_OUT_W, D_MODEL), ATTN_OUT_W ** -0.5)
    diff_lambda = nrm(ks[9], (n_even, 4, HEAD_DIM), 0.1)
    diff_subln_g = 1.0 + nrm(ks[10], (n_even, DIFF_V_DIM), 0.05)
    gqa_qk_g = 1.0 + nrm(ks[11], (n_even, 2, HEAD_DIM), 0.05)
    gdn_w_in = nrm(ks[12], (n_odd, D_MODEL, GDN_IN_W), D_MODEL ** -0.5)
    gdn_conv_w = nrm(ks[13], (n_odd, GDN_CONV_K, 3 * GDN_W), GDN_CONV_K ** -0.5)
    gdn_a_log = jnp.log(jax.random.uniform(ks[14], (n_odd, 2, GDN_HEADS), f32, 1.0, 16.0))
    dt = jnp.exp(jax.random.uniform(ks[15], (n_odd, 2, GDN_HEADS), f32, math.log(1e-3), math.log(1e-1)))
    gdn_dt_bias = dt + jnp.log(-jnp.expm1(-dt))
    gdn_norm_g = 1.0 + nrm(ks[16], (n_odd, GDN_HEAD_DIM), 0.05)
    gdn_w_out = nrm(ks[17], (n_odd, GDN_W, D_MODEL), GDN_W ** -0.5)
    ffn_w_gate_up = nrm(ks[18], (DEPTH, D_MODEL, 2 * FFN_HIDDEN), D_MODEL ** -0.5)
    ffn_w_down = nrm(ks[19], (DEPTH, FFN_HIDDEN, D_MODEL), FFN_HIDDEN ** -0.5)
    return {"x": x, "c": c, "ctx": ctx, "c_ctx": c_ctx, "ada_w": ada_w, "ada_b": ada_b,
            "norm_g": norm_g, "attn_w_in": attn_w_in, "attn_w_out": attn_w_out,
            "diff_lambda": diff_lambda, "diff_subln_g": diff_subln_g, "gqa_qk_g": gqa_qk_g,
            "gdn_w_in": gdn_w_in, "gdn_conv_w": gdn_conv_w, "gdn_a_log": gdn_a_log,
            "gdn_dt_bias": gdn_dt_bias, "gdn_norm_g": gdn_norm_g, "gdn_w_out": gdn_w_out,
            "ffn_w_gate_up": ffn_w_gate_up, "ffn_w_down": ffn_w_down}


def reference(x, c, ctx, c_ctx, ada_w, ada_b, norm_g, attn_w_in, attn_w_out, diff_lambda,
              diff_subln_g, gqa_qk_g, gdn_w_in, gdn_conv_w, gdn_a_log, gdn_dt_bias, gdn_norm_g,
              gdn_w_out, ffn_w_gate_up, ffn_w_down):
    n_tokens = x.shape[1]
    rows = n_tokens // GRID_W
    rope = axial_rope_tables(n_tokens, rows)
    x_ctx = ctx
    silu_c = jax.nn.silu(c)
    silu_cc = jax.nn.silu(c_ctx)
    for l in range(DEPTH):
        need_ctx = l < DEPTH - 1
        i = l // 2
        mod_lat = (silu_c @ ada_w[l] + ada_b[l])[:, None, :]
        mod_ctx = silu_cc @ ada_w[l] + ada_b[l]
        sh1, sc1, gt1, sh2, sc2, gt2 = jnp.split(mod_lat, 6, axis=-1)
        csh1, csc1, cgt1, csh2, csc2, cgt2 = jnp.split(mod_ctx, 6, axis=-1)
        h_lat = modulate(rms_norm(x, norm_g[l, 0]), sh1, sc1)
        h_ctx = modulate(rms_norm(x_ctx, norm_g[l, 0]), csh1, csc1)
        if l % 2 == 0:
            lam_init = 0.8 - 0.6 * math.exp(-0.3 * l)
            y_lat, y_ctx = even_mixer(h_lat, h_ctx, attn_w_in[i], attn_w_out[i], diff_lambda[i],
                                      diff_subln_g[i], gqa_qk_g[i], lam_init, rope, need_ctx)
        else:
            y_lat, y_ctx = odd_mixer(h_lat, h_ctx, gdn_w_in[i], gdn_conv_w[i], gdn_a_log[i],
                                     gdn_dt_bias[i], gdn_norm_g[i], gdn_w_out[i], need_ctx)
        x = x + gt1 * rms_norm(y_lat, norm_g[l, 1])
        h = modulate(rms_norm(x, norm_g[l, 2]), sh2, sc2)
        x = x + gt2 * rms_norm(swiglu(h, ffn_w_gate_up[l], ffn_w_down[l]), norm_g[l, 3])
        if need_ctx:
            x_ctx = x_ctx + cgt1 * rms_norm(y_ctx, norm_g[l, 1])
            hc = modulate(rms_norm(x_ctx, norm_g[l, 2]), csh2, csc2)
            x_ctx = x_ctx + cgt2 * rms_norm(swiglu(hc, ffn_w_gate_up[l], ffn_w_down[l]), norm_g[l, 3])
    return x
```

```cpp
#include <hip/hip_runtime.h>
#include <hip/hip_cooperative_groups.h>
#include <cstdio>
#include <cstdint>
namespace cg = cooperative_groups;
namespace pg8 {
#define PG8_LAS __attribute__((address_space(3)))
typedef unsigned short bf16_t;
typedef short bf16x8 __attribute__((ext_vector_type(8)));
typedef float f32x4 __attribute__((ext_vector_type(4)));
typedef unsigned u32x4 __attribute__((ext_vector_type(4)));
constexpr int BM = 256, BK = 64, HALF = 128, HTB = HALF * BK * 2  , STAGE_BYTES = 8 * HTB, NXCD = 8, WGM = 8;

__host__ __device__ __forceinline__ int lds_byte(int r, int c) { const int st = (r >> 4) * 2 + (c >> 5), rr = r & 15, cc = c & 31, ob = rr * 64 + cc * 2; return st * 1024 + (ob ^ (((ob >> 9) & 1) << 5)); }
__host__ __device__ __forceinline__ void stage_rc(int b, int& R, int& C) { const int st = b / 1024, sb = b % 1024, swz = sb ^ (((sb >> 9) & 1) << 5); R = (st >> 1) * 16 + swz / 64; C = (st & 1) * 32 + (swz % 64) / 2; }
__host__ __device__ __forceinline__ int perm32(int rho) { const int n = rho >> 4, i = rho & 15; return 8 * (i >> 2) + 4 * n + (i & 3); }

struct Unit { int pm, pn; };
struct Gemm { const bf16_t* A; const bf16_t* Bt; int M, N, K; };

struct StaticOrder {
    int nM, nN, nwg, G, c;
    __host__ __device__ void init(int M, int N, int G_, int c_) { nM = M / BM; nN = N / BM; nwg = nM * nN; G = G_; c = c_; }
    __host__ __device__ bool next(int i, Unit& u) const {
        const long L = (long)i * G + c; if (L >= nwg) return false;
        int wgid = (int)L; { const int q = nwg / NXCD, r = nwg % NXCD, xcd = wgid % NXCD, off = wgid / NXCD; wgid = (xcd < r ? xcd * (q + 1) : r * (q + 1) + (xcd - r) * q) + off; }
        const int nig = WGM * nN, gid = wgid / nig, fm = gid * WGM, gsz = (nM - fm) < WGM ? (nM - fm) : WGM;
        u.pm = fm + ((wgid % nig) % gsz); u.pn = (wgid % nig) / gsz; return true;
    }
    __device__ __forceinline__ void a_ready(const Unit&) const {}
    __device__ __forceinline__ void done(const Unit&) const {}
};

typedef float f32x2 __attribute__((ext_vector_type(2)));
typedef __bf16 bf16x2_t __attribute__((ext_vector_type(2)));
__device__ __forceinline__ unsigned cvt_pk_bf16(float lo, float hi) { f32x2 v = {lo, hi}; bf16x2_t b = __builtin_convertvector(v, bf16x2_t); return __builtin_bit_cast(unsigned, b); }
__device__ __forceinline__ float silu_f(float x) { return x * __builtin_amdgcn_rcpf(1.0f + __expf(-x)); }
struct EpiStore {
    static constexpr bool PERM = true, AFTER_DRAIN = false, ALIGN = true;
    bf16_t* O; int ldc;
    __device__ __forceinline__ void operator()(const f32x4 (&acc)[2][2][4][2], const Unit& u, int wr, int wc, int fr, int fq) const {
        const int row0 = u.pm * BM + wr * 64 + fr; const int col0 = u.pn * BM + wc * 32 + 8 * fq;
#pragma unroll
        for (int ai = 0; ai < 2; ++ai)
#pragma unroll
            for (int m = 0; m < 4; ++m) { bf16_t* rowp = O + (size_t)(row0 + ai * HALF + m * 16) * ldc + col0;
#pragma unroll
                for (int bj = 0; bj < 2; ++bj) { const f32x4 v0 = acc[ai][bj][m][0], v1 = acc[ai][bj][m][1];
                    u32x4 w; w.x = cvt_pk_bf16(v0[0], v0[1]); w.y = cvt_pk_bf16(v0[2], v0[3]); w.z = cvt_pk_bf16(v1[0], v1[1]); w.w = cvt_pk_bf16(v1[2], v1[3]);
                    *(u32x4*)(rowp + bj * HALF) = w; } }
    }
};
struct EpiSwiglu {
    static constexpr bool PERM = true, AFTER_DRAIN = false, ALIGN = true;
    bf16_t* O; int ldc;
    __device__ __forceinline__ void operator()(const f32x4 (&acc)[2][2][4][2], const Unit& u, int wr, int wc, int fr, int fq) const {
        const int row0 = u.pm * BM + wr * 64 + fr; const int col0 = u.pn * HALF + wc * 32 + 8 * fq;
#pragma unroll
        for (int ai = 0; ai < 2; ++ai)
#pragma unroll
            for (int m = 0; m < 4; ++m) { bf16_t* rowp = O + (size_t)(row0 + ai * HALF + m * 16) * ldc + col0;
                const f32x4 g0 = acc[ai][0][m][0], g1 = acc[ai][0][m][1], u0 = acc[ai][1][m][0], u1 = acc[ai][1][m][1];
                u32x4 w; w.x = cvt_pk_bf16(silu_f(g0[0]) * u0[0], silu_f(g0[1]) * u0[1]); w.y = cvt_pk_bf16(silu_f(g0[2]) * u0[2], silu_f(g0[3]) * u0[3]);
                w.z = cvt_pk_bf16(silu_f(g1[0]) * u1[0], silu_f(g1[1]) * u1[1]); w.w = cvt_pk_bf16(silu_f(g1[2]) * u1[2], silu_f(g1[3]) * u1[3]);
                __builtin_nontemporal_store(w, (u32x4*)rowp); }
    }
};

template <class Epi, class Sched, bool ALIGN_EPI = false, bool SP2 = false>
__device__ __forceinline__ void gemm_phase(PG8_LAS unsigned char* lds, const Gemm g, const Sched& S, const Epi& E, int wave_id) {
    int lane_; asm volatile("v_mbcnt_lo_u32_b32 %0, -1, 0\n\tv_mbcnt_hi_u32_b32 %0, -1, %0" : "=v"(lane_)); const int tid_ = wave_id * 64 + lane_;
    const int tid = tid_, wid = __builtin_amdgcn_readfirstlane(tid >> 6), lane = tid & 63, wr = wid >> 2, wc = wid & 3, fr = lane & 15, fq = lane >> 4;
    const int K = g.K, nt = K / BK;
    unsigned voffA[2], voffB[2];
#pragma unroll
    for (int i = 0; i < 2; ++i) { int R, C; stage_rc(tid * 16 + i * 8192, R, C); const int Rb = Epi::PERM ? ((R & ~31) + perm32(R & 31)) : R;
        voffA[i] = (unsigned)(R * K + C) * 2u; voffB[i] = (unsigned)(Rb * K + C) * 2u; }
    const size_t kstep = (size_t)(BK * 2);
    const size_t hstep = (size_t)HALF * K * 2;
    const size_t tstep = 2 * hstep;
    const unsigned ldsw = (unsigned)wid * 1024u;
    const int aoff = lds_byte(wr * 64 + fr, fq * 8), boff = lds_byte(wc * 32 + fr, fq * 8);
#define PG8_SA(b, h) (((b) * 2 + (h)) * HTB)
#define PG8_SB(b, h) ((4 + (b) * 2 + (h)) * HTB)
#define PG8_STAGE(bufoff, gbase, voff) do { _Pragma("unroll") for (int _i = 0; _i < 2; ++_i) \
        __builtin_amdgcn_global_load_lds((const unsigned*)((const char*)(gbase) + (voff)[_i]), (PG8_LAS unsigned*)(lds + (bufoff) + ldsw + _i * 8192), 16, 0, 0); } while (0)
#define PG8_LDA(dst, b, h) do { _Pragma("unroll") for (int m = 0; m < 4; ++m) _Pragma("unroll") for (int k = 0; k < 2; ++k) dst[m][k] = *(const PG8_LAS bf16x8*)(lds + PG8_SA(b, h) + aoff + m * 2048 + k * 1024); } while (0)
#define PG8_LDB(dst, b, h) do { _Pragma("unroll") for (int n = 0; n < 2; ++n) _Pragma("unroll") for (int k = 0; k < 2; ++k) dst[n][k] = *(const PG8_LAS bf16x8*)(lds + PG8_SB(b, h) + boff + n * 2048 + k * 1024); } while (0)
#define PG8_MMA(ai, bj, At, Bt) do { __builtin_amdgcn_s_setprio(1); _Pragma("unroll") for (int m = 0; m < 4; ++m) _Pragma("unroll") for (int n = 0; n < 2; ++n) _Pragma("unroll") for (int k = 0; k < 2; ++k) \
        acc[ai][bj][m][n] = __builtin_amdgcn_mfma_f32_16x16x32_bf16(Bt[n][k], At[m][k], acc[ai][bj][m][n], 0, 0, 0); __builtin_amdgcn_s_setprio(0); } while (0)
#define PG8_WAIT_V(n) asm volatile("s_waitcnt vmcnt(" #n ")" ::: "memory")
#define PG8_WAIT_L(n) asm volatile("s_waitcnt lgkmcnt(" #n ")" ::: "memory")
#define PG8_BAR __builtin_amdgcn_s_barrier()
#define PG8_SCHED __builtin_amdgcn_sched_barrier(0)
    Unit cur, nxt; int ui = 0;
    if (!S.next(0, cur)) return;
    f32x4 acc[2][2][4][2];
#pragma unroll
    for (int a = 0; a < 2; ++a)
#pragma unroll
        for (int b = 0; b < 2; ++b)
#pragma unroll
            for (int m = 0; m < 4; ++m)
#pragma unroll
                for (int n = 0; n < 2; ++n) acc[a][b][m][n] = (f32x4){0.f, 0.f, 0.f, 0.f};
    bf16x8 At[4][2], B0[2][2], B1[2][2];
    const char* cA = (const char*)g.A + (size_t)cur.pm * tstep; const char* cB = (const char*)g.Bt + (size_t)cur.pn * tstep;
    S.a_ready(cur);
    if constexpr (SP2) {
        PG8_STAGE(PG8_SB(0, 0), cB, voffB); PG8_STAGE(PG8_SB(0, 1), cB + hstep, voffB); PG8_STAGE(PG8_SA(0, 0), cA, voffA); PG8_STAGE(PG8_SA(0, 1), cA + hstep, voffA);
        if (wr == 1) PG8_BAR;
        PG8_WAIT_V(2); PG8_BAR;
        PG8_STAGE(PG8_SB(1, 0), cB + kstep, voffB); PG8_STAGE(PG8_SA(1, 0), cA + kstep, voffA); PG8_STAGE(PG8_SB(1, 1), cB + hstep + kstep, voffB);
        PG8_WAIT_V(6); PG8_BAR;
    } else {
        PG8_STAGE(PG8_SB(0, 0), cB, voffB); PG8_STAGE(PG8_SA(0, 0), cA, voffA); PG8_STAGE(PG8_SB(0, 1), cB + hstep, voffB); PG8_STAGE(PG8_SA(0, 1), cA + hstep, voffA);
        if (wr == 1) PG8_BAR;
        PG8_WAIT_V(4); PG8_BAR;
        PG8_STAGE(PG8_SB(1, 0), cB + kstep, voffB); PG8_STAGE(PG8_SA(1, 0), cA + kstep, voffA); PG8_STAGE(PG8_SB(1, 1), cB + hstep + kstep, voffB);
        PG8_WAIT_V(6); PG8_BAR;
    }
    for (;;) {
        const bool has_next = S.next(ui + 1, nxt);
        const char* nA = has_next ? (const char*)g.A + (size_t)nxt.pm * tstep : cA; const char* nB = has_next ? (const char*)g.Bt + (size_t)nxt.pn * tstep : cB;
        for (int t = 0; t < nt; t += 2) {
            const bool last = (t == nt - 2);
            const char* a1 = cA + (size_t)(t + 1) * kstep;
            const char* a2 = last ? nA : cA + (size_t)(t + 2) * kstep; const char* b2 = last ? nB : cB + (size_t)(t + 2) * kstep;
            const char* a3 = a2 + kstep; const char* b3 = b2 + kstep;
            if (last && has_next) S.a_ready(nxt);
            if constexpr (SP2) {
            PG8_LDB(B0, 0, 0); PG8_LDB(B1, 0, 1); PG8_SCHED; PG8_LDA(At, 0, 0); PG8_STAGE(PG8_SA(1, 1), a1 + hstep, voffA);
            PG8_WAIT_V(8); PG8_WAIT_L(0); PG8_BAR; PG8_MMA(0, 0, At, B0); PG8_MMA(0, 1, At, B1); PG8_BAR; PG8_SCHED;
            PG8_LDA(At, 0, 1); PG8_STAGE(PG8_SB(0, 0), b2, voffB); PG8_STAGE(PG8_SB(0, 1), b2 + hstep, voffB); PG8_STAGE(PG8_SA(0, 0), a2, voffA);
            PG8_WAIT_V(8); PG8_WAIT_L(0); PG8_BAR; PG8_MMA(1, 0, At, B0); PG8_MMA(1, 1, At, B1); PG8_BAR; PG8_SCHED;
            PG8_LDB(B0, 1, 0); PG8_LDB(B1, 1, 1); PG8_SCHED; PG8_LDA(At, 1, 0); PG8_STAGE(PG8_SA(0, 1), a2 + hstep, voffA);
            PG8_WAIT_V(8); PG8_WAIT_L(0); PG8_BAR; PG8_MMA(0, 0, At, B0); PG8_MMA(0, 1, At, B1); PG8_BAR; PG8_SCHED;
            PG8_LDA(At, 1, 1); PG8_STAGE(PG8_SB(1, 0), b3, voffB); PG8_STAGE(PG8_SB(1, 1), b3 + hstep, voffB); PG8_STAGE(PG8_SA(1, 0), a3, voffA);
            PG8_WAIT_V(8); PG8_WAIT_L(0); PG8_BAR; PG8_MMA(1, 0, At, B0); PG8_MMA(1, 1, At, B1); PG8_BAR; PG8_SCHED;
            } else {
            PG8_LDB(B0, 0, 0); PG8_SCHED; PG8_LDA(At, 0, 0); PG8_STAGE(PG8_SA(1, 1), a1 + hstep, voffA);
            PG8_WAIT_L(8); PG8_BAR; PG8_WAIT_L(0); PG8_MMA(0, 0, At, B0); PG8_BAR; PG8_SCHED;
            PG8_LDB(B1, 0, 1); PG8_STAGE(PG8_SB(0, 0), b2, voffB);
            PG8_BAR; PG8_WAIT_L(0); PG8_MMA(0, 1, At, B1); PG8_BAR;
            PG8_LDA(At, 0, 1); PG8_STAGE(PG8_SA(0, 0), a2, voffA);
            PG8_BAR; PG8_WAIT_L(0); PG8_MMA(1, 0, At, B0); PG8_BAR; PG8_SCHED;
            PG8_STAGE(PG8_SB(0, 1), b2 + hstep, voffB);
            PG8_WAIT_V(6); PG8_BAR; PG8_MMA(1, 1, At, B1); PG8_BAR;
            PG8_LDB(B0, 1, 0); PG8_SCHED; PG8_LDA(At, 1, 0); PG8_STAGE(PG8_SA(0, 1), a2 + hstep, voffA);
            PG8_WAIT_L(8); PG8_BAR; PG8_WAIT_L(0); PG8_MMA(0, 0, At, B0); PG8_BAR; PG8_SCHED;
            PG8_LDB(B1, 1, 1); PG8_STAGE(PG8_SB(1, 0), b3, voffB);
            PG8_BAR; PG8_WAIT_L(0); PG8_MMA(0, 1, At, B1); PG8_BAR;
            PG8_LDA(At, 1, 1); PG8_STAGE(PG8_SA(1, 0), a3, voffA);
            PG8_BAR; PG8_WAIT_L(0); PG8_MMA(1, 0, At, B0); PG8_BAR; PG8_SCHED;
            PG8_STAGE(PG8_SB(1, 1), b3 + hstep, voffB);
            PG8_WAIT_V(6); PG8_BAR; PG8_MMA(1, 1, At, B1); PG8_BAR;
            }
        }
        if constexpr (ALIGN_EPI) { if (wr == 0) PG8_BAR; }
        if constexpr (!Epi::AFTER_DRAIN) { E(acc, cur, wr, wc, fr, fq); S.done(cur); }
        if (!has_next) break;
#pragma unroll
        for (int a = 0; a < 2; ++a)
#pragma unroll
            for (int b = 0; b < 2; ++b)
#pragma unroll
                for (int m = 0; m < 4; ++m)
#pragma unroll
                    for (int n = 0; n < 2; ++n) acc[a][b][m][n] = (f32x4){0.f, 0.f, 0.f, 0.f};
        cur = nxt; cA = nA; cB = nB; ++ui;
        if constexpr (ALIGN_EPI) { if (wr == 1) PG8_BAR; }
    }
    PG8_WAIT_V(0);
    if constexpr (!ALIGN_EPI) { if (wr == 0) PG8_BAR; }
    PG8_BAR;
    if constexpr (Epi::AFTER_DRAIN) { E.fused(acc, cur, wr, wc, fr, fq, lds, wid, lane); S.done(cur); }
#undef PG8_SA
#undef PG8_SB
#undef PG8_STAGE
#undef PG8_LDA
#undef PG8_LDB
#undef PG8_MMA
#undef PG8_WAIT_V
#undef PG8_WAIT_L
#undef PG8_BAR
#undef PG8_SCHED
}
}
#define LAS __attribute__((address_space(3)))
#define DI __device__ __forceinline__
typedef unsigned short bf16_t;
typedef short bf16x8 __attribute__((ext_vector_type(8)));
typedef short s16x4 __attribute__((ext_vector_type(4)));
typedef float f32x4 __attribute__((ext_vector_type(4)));
typedef float f32x16 __attribute__((ext_vector_type(16)));
typedef unsigned u32x4 __attribute__((ext_vector_type(4)));
typedef unsigned u32x2 __attribute__((ext_vector_type(2)));
typedef float f32x2 __attribute__((ext_vector_type(2)));
using pg8::cvt_pk_bf16;
using pg8::silu_f;

constexpr int NTHREADS = 512, NWAVES = 8;
constexpr int DM = 1024, T_LAT = 65536, T_CTX = 8192, T_ALL = T_LAT + T_CTX, SEQ = 2048, CTXL = 256, NB = 32;
constexpr int ATT_W = 2304, GDN_W = 4352, GDN_WREAL = 4128, FFH = 2816;
constexpr float RMS_EPS = 1e-6f;
constexpr int LDS_BYTES = 163840;
constexpr size_t MiB = 1u << 20;
constexpr size_t WS_BAR = 3670016;
constexpr size_t WS_MOD = 0, WS_WIN = 4 * MiB, WS_WOUT = 13 * MiB, WS_WGU = 15 * MiB, WS_WDN = 26 * MiB, WS_XCTX = 32 * MiB, WS_H = 64 * MiB, WS_Y = 208 * MiB, WS_BIG = 352 * MiB, WS_END = 964 * MiB;

struct Args { const float* in[20]; float* out; unsigned char* ws; int ph_lo, ph_hi; };
enum { I_X = 0, I_C, I_CTX, I_CCTX, I_ADAW, I_ADAB, I_NORMG, I_AWIN, I_AWOUT, I_DLAM, I_SUBLN, I_QKG, I_GWIN, I_GCONV, I_GALOG, I_GDT, I_GNORM, I_GWOUT, I_FGU, I_FDN };

DI float bf2f(bf16_t b) { return __uint_as_float((unsigned)b << 16); }
DI float bflo(unsigned u) { return __uint_as_float(u << 16); }
DI float bfhi(unsigned u) { return __uint_as_float(u & 0xffff0000u); }
DI bf16_t f2bf(float f) { return (bf16_t)(cvt_pk_bf16(f, 0.f) & 0xffffu); }
template <int OFF> DI float shx(float v) { return __int_as_float(__builtin_amdgcn_ds_swizzle(__float_as_int(v), (OFF << 10) | 0x1f)); }
DI float swp_other(float v, int h) { auto rr = __builtin_amdgcn_permlane32_swap(__float_as_uint(v), __float_as_uint(v), false, false); return __uint_as_float(h ? rr[0] : rr[1]); }
DI float swp_sum(float v) { auto rr = __builtin_amdgcn_permlane32_swap(__float_as_uint(v), __float_as_uint(v), false, false); return __uint_as_float(rr[0]) + __uint_as_float(rr[1]); }
DI float swp_max(float v) { auto rr = __builtin_amdgcn_permlane32_swap(__float_as_uint(v), __float_as_uint(v), false, false); return fmaxf(__uint_as_float(rr[0]), __uint_as_float(rr[1])); }
DI float wave_sum(float v) { v += shx<1>(v); v += shx<2>(v); v += shx<4>(v); v += shx<8>(v); v += shx<16>(v); return swp_sum(v); }
#define MFMA32(a, b, c) __builtin_amdgcn_mfma_f32_32x32x16_bf16((a), (b), (c), 0, 0, 0)
DI int crow(int r, int h) { return (r & 3) + 8 * (r >> 2) + 4 * h; }
template <int S> DI bf16x8 pack_step(const f32x16& x) {
    u32x4 p; p.x = cvt_pk_bf16(x[8 * S], x[8 * S + 1]); p.y = cvt_pk_bf16(x[8 * S + 2], x[8 * S + 3]); p.z = cvt_pk_bf16(x[8 * S + 4], x[8 * S + 5]); p.w = cvt_pk_bf16(x[8 * S + 6], x[8 * S + 7]);
    return __builtin_bit_cast(bf16x8, p);
}
typedef short v4i16_t __attribute__((ext_vector_type(4)));
DI s16x4 tr_read(LAS const unsigned char* p) { return __builtin_bit_cast(s16x4, __builtin_amdgcn_ds_read_tr16_b64_v4i16((LAS v4i16_t*)p)); }
DI bf16x8 cat8(s16x4 lo, s16x4 hi) { return __builtin_shufflevector(lo, hi, 0, 1, 2, 3, 4, 5, 6, 7); }

struct Ctx {
    const float* const __attribute__((address_space(4)))* in; float* out; unsigned char* ws;
    LAS unsigned char* lds; int wave, G, gw, ngw;
};
DI int get_lane() { int l; asm volatile("v_mbcnt_lo_u32_b32 %0, -1, 0\n\tv_mbcnt_hi_u32_b32 %0, -1, %0" : "=v"(l)); return l; }
#define PHASE_IDS const int LANE = get_lane(); const int TID = F.wave * 64 + LANE; (void)TID;

DI float* xrow(const Ctx& F, int m) { return m < T_LAT ? F.out + (size_t)m * DM : (float*)(F.ws + WS_XCTX) + (size_t)(m - T_LAT) * DM; }
DI const float* xin(const Ctx& F, int m) { return m < T_LAT ? F.in[I_X] + (size_t)m * DM : F.in[I_CTX] + (size_t)(m - T_LAT) * DM; }

DI void transpose_item(const float* W, int K, int N, bf16_t* WT, int k0, int n0, int drow0, LAS float* scr, int lane) {
#pragma unroll 8
    for (int i = 0; i < 32; ++i) { const int kk = 2 * i + (lane >> 5); scr[kk * 33 + (lane & 31)] = __builtin_nontemporal_load(W + (size_t)(k0 + kk) * N + n0 + (lane & 31)); }
    asm volatile("s_waitcnt lgkmcnt(0)" ::: "memory");
    const int c = lane & 7;
#pragma unroll
    for (int j = 0; j < 4; ++j) { const int n = (lane >> 3) + 8 * j; const LAS float* s = scr + (8 * c) * 33 + n;
        u32x4 o; o.x = cvt_pk_bf16(s[0 * 33], s[1 * 33]); o.y = cvt_pk_bf16(s[2 * 33], s[3 * 33]); o.z = cvt_pk_bf16(s[4 * 33], s[5 * 33]); o.w = cvt_pk_bf16(s[6 * 33], s[7 * 33]);
        *(u32x4*)(WT + (size_t)(drow0 + n) * K + k0 + 8 * c) = o; }
    asm volatile("s_waitcnt lgkmcnt(0)" ::: "memory");
}
DI void wconv_layer(const Ctx& F, int l) {
    PHASE_IDS
    LAS float* scr = (LAS float*)(F.lds + F.wave * 8448);
    const int i2 = l >> 1; const bool odd = l & 1;
    const float* Win = odd ? F.in[I_GWIN] + (size_t)i2 * DM * GDN_WREAL : F.in[I_AWIN] + (size_t)i2 * DM * ATT_W;
    const float* Wout = odd ? F.in[I_GWOUT] + (size_t)i2 * DM * DM : F.in[I_AWOUT] + (size_t)i2 * DM * DM;
    const float* Wgu = F.in[I_FGU] + (size_t)l * DM * 2 * FFH; const float* Wdn = F.in[I_FDN] + (size_t)l * FFH * DM;
    bf16_t* win_t = (bf16_t*)(F.ws + WS_WIN); bf16_t* wout_t = (bf16_t*)(F.ws + WS_WOUT); bf16_t* wgu_t = (bf16_t*)(F.ws + WS_WGU); bf16_t* wdn_t = (bf16_t*)(F.ws + WS_WDN);
    const int Nin = odd ? GDN_WREAL : ATT_W;
    const int n_in = 16 * (Nin / 32), n_out = 16 * 32, n_gu = 16 * (2 * FFH / 32), n_dn = (FFH / 64) * 32, n_zero = odd ? (GDN_W - GDN_WREAL) : 0;
    const int total = n_in + n_out + n_gu + n_dn + n_zero;
    for (int it = F.gw; it < total; it += F.ngw) {
        int r = it;
        if (r < n_in) { const int nb = Nin / 32, kb = r / nb, nn = r % nb; transpose_item(Win, DM, Nin, win_t, 64 * kb, 32 * nn, 32 * nn, scr, LANE); continue; } r -= n_in;
        if (r < n_out) { const int kb = r / 32, nn = r % 32; transpose_item(Wout, DM, DM, wout_t, 64 * kb, 32 * nn, 32 * nn, scr, LANE); continue; } r -= n_out;
        if (r < n_gu) { const int nb = 2 * FFH / 32, kb = r / nb, nn = r % nb; const int n0 = 32 * nn, half = n0 / FFH, jj = n0 % FFH; const int drow = (jj / 128) * 256 + half * 128 + (jj % 128);
            transpose_item(Wgu, DM, 2 * FFH, wgu_t, 64 * kb, n0, drow, scr, LANE); continue; } r -= n_gu;
        if (r < n_dn) { const int kb = r / 32, nn = r % 32; transpose_item(Wdn, FFH, DM, wdn_t, 64 * kb, 32 * nn, 32 * nn, scr, LANE); continue; } r -= n_dn;
        { u32x4 z = {0u, 0u, 0u, 0u}; u32x4* p = (u32x4*)(win_t + (size_t)(GDN_WREAL + r) * DM); p[LANE] = z; p[LANE + 64] = z; }
    }
}

DI void modvec_phase(const Ctx& F) {
    PHASE_IDS
    LAS float* sc = (LAS float*)F.lds;
    float* MOD = (float*)(F.ws + WS_MOD);
    for (int it = blockIdx.x; it < 4 * 96; it += F.G) {
        for (int idx = TID; idx < 33 * 1024; idx += NTHREADS) { const int bb = idx >> 10, k = idx & 1023; const float v = bb < 32 ? F.in[I_C][bb * 1024 + k] : F.in[I_CCTX][k]; sc[idx] = silu_f(v); }
        __syncthreads();
        const int l = it / 96, col = (it % 96) * 64 + LANE, k0 = F.wave * 128;
        const float* w = F.in[I_ADAW] + (size_t)l * DM * 6144 + col;
        float acc[33];
#pragma unroll
        for (int i = 0; i < 33; ++i) acc[i] = 0.f;
        for (int k = k0; k < k0 + 128; k += 16) {
            float wv[16];
#pragma unroll
            for (int j = 0; j < 16; ++j) wv[j] = __builtin_nontemporal_load(w + (size_t)(k + j) * 6144);
            int zd = 0;
#pragma unroll
            for (int j4 = 0; j4 < 4; ++j4) {
                const LAS unsigned char* scb = (const LAS unsigned char*)(sc + k + 4 * j4) + zd;
#pragma unroll
                for (int i = 0; i < 33; ++i) { const f32x4 s = *(const LAS f32x4*)(scb + i * 4096); acc[i] += (s[0] * wv[4 * j4] + s[1] * wv[4 * j4 + 1]) + (s[2] * wv[4 * j4 + 2] + s[3] * wv[4 * j4 + 3]); }
                asm volatile("v_and_b32 %0, 0, %1" : "=v"(zd) : "v"(acc[0]), "v"(acc[8]), "v"(acc[16]), "v"(acc[24]), "v"(acc[32]));
            }
        }
        __syncthreads();
#pragma unroll
        for (int i = 0; i < 33; ++i) sc[(F.wave * 33 + i) * 64 + LANE] = acc[i];
        __syncthreads();
        const float* bs = F.in[I_ADAB] + l * 6144 + (it % 96) * 64;
        for (int o = TID; o < 33 * 64; o += NTHREADS) { const int bb = o >> 6, c = o & 63; float sum = bs[c];
#pragma unroll
            for (int wv_ = 0; wv_ < 8; ++wv_) sum += sc[(wv_ * 33 + bb) * 64 + c];
            MOD[(size_t)(l * 33 + bb) * 6144 + (it % 96) * 64 + c] = sum; }
        __syncthreads();
    }
}

DI void rowwise_phase(const Ctx& F, int stage, int l, int Mrows) {
    PHASE_IDS
    const float* MOD = (const float*)(F.ws + WS_MOD); const float* NG = F.in[I_NORMG];
    bf16_t* H = (bf16_t*)(F.ws + WS_H); const bf16_t* Y = (const bf16_t*)(F.ws + WS_Y);
    const bool needh = !(stage == 2 && l == 3), xfromin = (stage == 0) || (stage == 1 && l == 0);
    const int lh = (stage == 2) ? l + 1 : l;
    const int rpw = (Mrows + F.ngw - 1) / F.ngw, mb = F.gw * rpw, me = (mb + rpw < Mrows) ? mb + rpw : Mrows;
    if (mb >= me) return;
    f32x4 ga[4], gb[4], gt[4], sh[4], sc[4];
#pragma unroll
    for (int j = 0; j < 4; ++j) { ga[j] = (f32x4){0.f, 0.f, 0.f, 0.f}; gb[j] = ga[j]; gt[j] = ga[j]; sh[j] = ga[j]; sc[j] = ga[j]; }
    if (stage != 0) { const float* gap = NG + (size_t)(l * 4 + (stage == 1 ? 1 : 3)) * DM;
#pragma unroll
        for (int j = 0; j < 4; ++j) ga[j] = ((const f32x4*)gap)[LANE + 64 * j]; }
    if (needh) { const float* gbp = NG + (size_t)(lh * 4 + (stage == 1 ? 2 : 0)) * DM;
#pragma unroll
        for (int j = 0; j < 4; ++j) gb[j] = ((const f32x4*)gbp)[LANE + 64 * j]; }
    int cur_bb = -1;
    bf16_t* XL = (bf16_t*)((unsigned char*)F.out + 128 * MiB); float* XF = (float*)(F.ws + WS_BIG + 352 * MiB); float* XC = (float*)(F.ws + WS_XCTX);
    f32x4 xn[4]; u32x2 yn[4], xbn[4];
#define RW_SRC16(m_) (!xfromin && (m_) < T_LAT && !(l == 3 && stage == 2))
#define RW_FETCH(m_) do { if (RW_SRC16(m_)) { const u32x2* xb_ = (const u32x2*)(XL + (size_t)(m_) * DM) + LANE; _Pragma("unroll") for (int j = 0; j < 4; ++j) xbn[j] = __builtin_nontemporal_load(xb_ + 64 * j); } \
        else { const float* xr_ = xfromin ? xin(F, (m_)) : ((m_) >= T_LAT ? XC + (size_t)((m_) - T_LAT) * DM : XF + (size_t)(m_) * DM); const f32x4* xp_ = (const f32x4*)xr_ + LANE; \
            _Pragma("unroll") for (int j = 0; j < 4; ++j) xn[j] = __builtin_nontemporal_load(xp_ + 64 * j); } \
        if (stage != 0) { const u32x2* yp_ = (const u32x2*)(Y + (size_t)(m_) * DM) + LANE; _Pragma("unroll") for (int j = 0; j < 4; ++j) yn[j] = __builtin_nontemporal_load(yp_ + 64 * j); } } while (0)
#pragma unroll
    for (int j = 0; j < 4; ++j) { yn[j] = (u32x2){0u, 0u}; xbn[j] = (u32x2){0u, 0u}; xn[j] = (f32x4){0.f, 0.f, 0.f, 0.f}; }
    RW_FETCH(mb);
    for (int m = mb; m < me; ++m) {
        f32x4 x[4]; u32x2 yw[4];
#pragma unroll
        for (int j = 0; j < 4; ++j) { x[j] = RW_SRC16(m) ? (f32x4){bflo(xbn[j].x), bfhi(xbn[j].x), bflo(xbn[j].y), bfhi(xbn[j].y)} : xn[j]; yw[j] = yn[j]; }
        if (m + 1 < me) RW_FETCH(m + 1);
        const int bb = m < T_LAT ? (m >> 11) : 32;
        if (bb != cur_bb) { cur_bb = bb;
            if (stage != 0) { const float* md = MOD + (size_t)(l * 33 + bb) * 6144 + (stage == 1 ? 2 * 1024 : 5 * 1024);
#pragma unroll
                for (int j = 0; j < 4; ++j) gt[j] = ((const f32x4*)md)[LANE + 64 * j]; }
            if (needh) { const float* md = MOD + (size_t)(lh * 33 + bb) * 6144 + (stage == 1 ? 3 * 1024 : 0);
#pragma unroll
                for (int j = 0; j < 4; ++j) { sh[j] = ((const f32x4*)md)[LANE + 64 * j]; sc[j] = ((const f32x4*)(md + 1024))[LANE + 64 * j]; } }
        }
        if (stage != 0) {
            f32x4 y[4]; float ss = 0.f;
#pragma unroll
            for (int j = 0; j < 4; ++j) { y[j] = (f32x4){bflo(yw[j].x), bfhi(yw[j].x), bflo(yw[j].y), bfhi(yw[j].y)}; ss += (y[j][0] * y[j][0] + y[j][1] * y[j][1]) + (y[j][2] * y[j][2] + y[j][3] * y[j][3]); }
            const float ry = rsqrtf(wave_sum(ss) * (1.f / DM) + RMS_EPS);
#pragma unroll
            for (int j = 0; j < 4; ++j) x[j] = x[j] + gt[j] * (y[j] * ry * ga[j]);
            if (m < T_LAT && l != 3) { u32x2* xo = (u32x2*)(XL + (size_t)m * DM) + LANE;
#pragma unroll
                for (int j = 0; j < 4; ++j) { u32x2 w; w.x = cvt_pk_bf16(x[j][0], x[j][1]); w.y = cvt_pk_bf16(x[j][2], x[j][3]); __builtin_nontemporal_store(w, xo + 64 * j); } }
            else { float* xr = (m >= T_LAT) ? XC + (size_t)(m - T_LAT) * DM : (stage == 1 ? XF + (size_t)m * DM : F.out + (size_t)m * DM); f32x4* xo = (f32x4*)xr + LANE;
#pragma unroll
                for (int j = 0; j < 4; ++j) xo[64 * j] = x[j]; }
        }
        if (!needh) continue;
        float s2 = 0.f;
#pragma unroll
        for (int j = 0; j < 4; ++j) s2 += (x[j][0] * x[j][0] + x[j][1] * x[j][1]) + (x[j][2] * x[j][2] + x[j][3] * x[j][3]);
        const float rx = rsqrtf(wave_sum(s2) * (1.f / DM) + RMS_EPS);
        u32x2* hp = (u32x2*)(H + (size_t)m * DM) + LANE;
#pragma unroll
        for (int j = 0; j < 4; ++j) { const f32x4 hv = (x[j] * rx * gb[j]) * (sc[j] + 1.0f) + sh[j]; u32x2 w; w.x = cvt_pk_bf16(hv[0], hv[1]); w.y = cvt_pk_bf16(hv[2], hv[3]); hp[64 * j] = w; }
    }
#undef RW_FETCH
#undef RW_SRC16
}
constexpr float QSCALE = 0.125f * 1.4426950408889634f;
DI void attn_prep_phase(const Ctx& F, int i2) {
    PHASE_IDS
    bf16_t* P = (bf16_t*)(F.ws + WS_BIG);
    const int sub = LANE & 15, hsel = LANE >> 4;
    const f32x4 qg0 = *(const f32x4*)(F.in[I_QKG] + (i2 * 2 + 0) * 64 + 4 * sub), qg1 = *(const f32x4*)(F.in[I_QKG] + (i2 * 2 + 1) * 64 + 4 * sub);
    float inv_freq[4];
#pragma unroll
    for (int e = 0; e < 4; ++e) inv_freq[e] = exp2f(-(float)(2 * (4 * (sub & 3) + e)) * (1.0f / 32.0f) * 13.287712379549449f);
    const float sgn = (sub & 4) ? 1.0f : -1.0f;
    const int rpw = (T_ALL + F.ngw - 1) / F.ngw, mb = F.gw * rpw, me = (mb + rpw < T_ALL) ? mb + rpw : T_ALL;
    u32x2 wn[7];
#define AP_FETCH(m_) do { const bf16_t* row_ = P + (size_t)(m_) * ATT_W + hsel * 64 + 4 * sub; \
        _Pragma("unroll") for (int g = 0; g < 7; ++g) { const int c0 = (g < 4) ? 256 * g : 1536 + 256 * (g - 4); wn[g] = (u32x2){0u, 0u}; if (g == 2 || g == 3 || (g == 6 && hsel < 2)) wn[g] = __builtin_nontemporal_load((const u32x2*)(row_ + c0)); } } while (0)
    if (mb < me) AP_FETCH(mb);
    for (int m = mb; m < me; ++m) {
        bf16_t* row = P + (size_t)m * ATT_W + hsel * 64 + 4 * sub;
        float cs[4] = {1.f, 1.f, 1.f, 1.f}, sn[4] = {0.f, 0.f, 0.f, 0.f};
        if (m < T_LAT) { const int t = m & (SEQ - 1); const float pos = (float)((sub < 8) ? (t >> 6) : (t & 63));
#pragma unroll
            for (int e = 0; e < 4; ++e) sincosf(pos * inv_freq[e], &sn[e], &cs[e]); }
        u32x2 w[7];
#pragma unroll
        for (int g = 0; g < 7; ++g) w[g] = wn[g];
        if (m + 1 < me) AP_FETCH(m + 1);
#pragma unroll
        for (int g = 0; g < 7; ++g) {
            if (!(g == 2 || g == 3 || g == 6)) continue;
            float v[4] = {bflo(w[g].x), bfhi(w[g].x), bflo(w[g].y), bfhi(w[g].y)};
            if (g >= 4) { float ss = (v[0] * v[0] + v[1] * v[1]) + (v[2] * v[2] + v[3] * v[3]); ss += shx<1>(ss); ss += shx<2>(ss); ss += shx<4>(ss); ss += shx<8>(ss);
                const float rs = rsqrtf(ss * (1.0f / 64.0f) + RMS_EPS); const f32x4 gg = (g < 6) ? qg0 : qg1;
#pragma unroll
                for (int e = 0; e < 4; ++e) v[e] = v[e] * rs * gg[e]; }
            const float scl = (g < 2 || g == 4 || g == 5) ? QSCALE : 1.0f;
            float o[4];
#pragma unroll
            for (int e = 0; e < 4; ++e) { const float pr = shx<4>(v[e]); o[e] = (v[e] * cs[e] + sgn * pr * sn[e]) * scl; }
            const int c0 = (g < 4) ? 256 * g : 1536 + 256 * (g - 4);
            u32x2 ow; ow.x = cvt_pk_bf16(o[0], o[1]); ow.y = cvt_pk_bf16(o[2], o[3]);
            if (g < 6 || hsel < 2) *(u32x2*)(row + c0) = ow;
        }
    }
}

constexpr int AK_PITCH = 144, AK_BYTES = 64 * AK_PITCH;
template <int DVT> struct AttnGeo { static constexpr int VP = (DVT == 4) ? 320 : 192, VBYTES = 64 * VP, VOFF = 4 * AK_BYTES; };
template <int DVT>
DI void attn_pass(f32x16 (&acc)[DVT], float& lsum, const Ctx& F, const bf16_t* P, int b, bool ctxq, int qrow, int qcol, int kcol, int vcol, const float* qgam) {
    PHASE_IDS
    typedef AttnGeo<DVT> GEO;
    const int lane = LANE, tid = TID, l31 = lane & 31, h = lane >> 5;
    LAS unsigned char* lds = F.lds;
    const int nt = ctxq ? 4 : 36;
    bf16x8 qf[4];
    {
        float q[4][8];
#pragma unroll
        for (int ks = 0; ks < 4; ++ks) { const u32x4 w = __builtin_nontemporal_load((const u32x4*)(P + (size_t)qrow * ATT_W + qcol + ks * 16 + h * 8));
            q[ks][0] = bflo(w.x); q[ks][1] = bfhi(w.x); q[ks][2] = bflo(w.y); q[ks][3] = bfhi(w.y); q[ks][4] = bflo(w.z); q[ks][5] = bfhi(w.z); q[ks][6] = bflo(w.w); q[ks][7] = bfhi(w.w); }
        if (qgam) {
            float ss = 0.f;
#pragma unroll
            for (int ks = 0; ks < 4; ++ks)
#pragma unroll
                for (int j = 0; j < 8; ++j) ss += q[ks][j] * q[ks][j];
            ss = swp_sum(ss);
            const float rs = rsqrtf(ss * (1.0f / 64.0f) + RMS_EPS);
#pragma unroll
            for (int ks = 0; ks < 4; ++ks) { const f32x4 g0 = *(const f32x4*)(qgam + ks * 16 + h * 8), g1 = *(const f32x4*)(qgam + ks * 16 + h * 8 + 4);
#pragma unroll
                for (int j = 0; j < 4; ++j) { q[ks][j] *= rs * g0[j]; q[ks][4 + j] *= rs * g1[j]; } }
        }
        if (!ctxq) {
            const int tq = qrow & (SEQ - 1); const float pr = (float)(tq >> 6), pc = (float)(tq & 63);
#pragma unroll
            for (int j = 0; j < 8; ++j) {
                const float fr = exp2f(-(float)(2 * (8 * h + j)) * (1.0f / 32.0f) * 13.287712379549449f);
                const float sr = __sinf(pr * fr), cr = __cosf(pr * fr), sc_ = __sinf(pc * fr), cc = __cosf(pc * fr);
                const float a0 = q[0][j], a1 = q[1][j], b0 = q[2][j], b1 = q[3][j];
                q[0][j] = a0 * cr - a1 * sr; q[1][j] = a1 * cr + a0 * sr; q[2][j] = b0 * cc - b1 * sc_; q[3][j] = b1 * cc + b0 * sc_;
            }
        }
#pragma unroll
        for (int ks = 0; ks < 4; ++ks) { u32x4 w; w.x = cvt_pk_bf16(q[ks][0] * QSCALE, q[ks][1] * QSCALE); w.y = cvt_pk_bf16(q[ks][2] * QSCALE, q[ks][3] * QSCALE); w.z = cvt_pk_bf16(q[ks][4] * QSCALE, q[ks][5] * QSCALE); w.w = cvt_pk_bf16(q[ks][6] * QSCALE, q[ks][7] * QSCALE);
            qf[ks] = __builtin_bit_cast(bf16x8, w); }
    }
#pragma unroll
    for (int t = 0; t < DVT; ++t)
#pragma unroll
        for (int r = 0; r < 16; ++r) acc[t][r] = 0.f;
    float mrun = 0.f; lsum = 0.f;
    float nref = 0.f;
    const int krow_s = tid >> 3, kch = tid & 7;
    u32x4 kregA, vregA[DVT / 2];
#define A_ROWBASE(t) ((t) < 4 ? (T_LAT + b * CTXL + 64 * (t)) : (b * SEQ + 64 * ((t) - 4)))
#define A_GLOAD(t, kreg, vreg) do { const int rb_ = A_ROWBASE(t); kreg = *(const u32x4*)(P + (size_t)(rb_ + krow_s) * ATT_W + kcol + kch * 8); \
        if (DVT == 4) { _Pragma("unroll") for (int i_ = 0; i_ < DVT / 2; ++i_) { const int idx_ = tid + 512 * i_; vreg[i_] = *(const u32x4*)(P + (size_t)(rb_ + (idx_ >> 4)) * ATT_W + vcol + (idx_ & 15) * 8); } } \
        else { vreg[0] = *(const u32x4*)(P + (size_t)(rb_ + krow_s) * ATT_W + vcol + kch * 8); } } while (0)
#define A_LSTORE(buf, kreg, vreg) do { *(LAS u32x4*)(lds + (buf) * AK_BYTES + krow_s * AK_PITCH + kch * 16) = kreg;   \
        if (DVT == 4) { _Pragma("unroll") for (int i_ = 0; i_ < DVT / 2; ++i_) { const int idx_ = tid + 512 * i_; *(LAS u32x4*)(lds + GEO::VOFF + (buf) * GEO::VBYTES + (idx_ >> 4) * GEO::VP + (idx_ & 15) * 16) = vreg[i_]; } } \
        else { *(LAS u32x4*)(lds + GEO::VOFF + (buf) * GEO::VBYTES + krow_s * GEO::VP + kch * 16) = vreg[0]; } } while (0)
    const int q4 = (lane & 15) >> 2, p4 = lane & 3, blk = (lane >> 4) & 1;
#define A_TILE(t, cur) do { \
        f32x16 s0, s1; _Pragma("unroll") for (int r = 0; r < 16; ++r) { s0[r] = nref; s1[r] = nref; } \
        const LAS unsigned char* kb = lds + (cur) * AK_BYTES + l31 * AK_PITCH + h * 16; \
        _Pragma("unroll") for (int ks = 0; ks < 4; ++ks) { \
            const bf16x8 a0 = *(const LAS bf16x8*)(kb + ks * 32), a1 = *(const LAS bf16x8*)(kb + 32 * AK_PITCH + ks * 32); \
            s0 = MFMA32(a0, qf[ks], s0); s1 = MFMA32(a1, qf[ks], s1); } \
        float mx = fmaxf(fmaxf(s0[0], s0[1]), s1[0]); \
        _Pragma("unroll") for (int r = 2; r < 16; r += 2) mx = fmaxf(fmaxf(mx, s0[r]), s0[r + 1]); \
        _Pragma("unroll") for (int r = 1; r < 15; r += 2) mx = fmaxf(fmaxf(mx, s1[r]), s1[r + 1]); \
        mx = fmaxf(mx, s1[15]); \
        mx = swp_max(mx); \
        if ((t) == 0 || __builtin_amdgcn_ballot_w64(mx > 6.0f) != 0ull) { \
            const float dl = ((t) == 0) ? mx : fmaxf(mx, 0.f), alpha = ((t) == 0) ? 1.0f : __builtin_amdgcn_exp2f(-dl); \
            mrun += dl; lsum *= alpha; \
            _Pragma("unroll") for (int r = 0; r < 16; ++r) { s0[r] -= dl; s1[r] -= dl; } nref = -mrun; \
            _Pragma("unroll") for (int tt = 0; tt < DVT; ++tt) _Pragma("unroll") for (int r = 0; r < 16; ++r) acc[tt][r] *= alpha; } \
        float psum = 0.f; \
        _Pragma("unroll") for (int r = 0; r < 16; ++r) { s0[r] = __builtin_amdgcn_exp2f(s0[r]); s1[r] = __builtin_amdgcn_exp2f(s1[r]); psum += s0[r] + s1[r]; } \
        lsum += psum; \
        bf16x8 pf[4]; pf[0] = pack_step<0>(s0); pf[1] = pack_step<1>(s0); pf[2] = pack_step<0>(s1); pf[3] = pack_step<1>(s1); \
        const LAS unsigned char* vb = lds + GEO::VOFF + (cur) * GEO::VBYTES + (4 * h + q4) * GEO::VP + (16 * blk + 4 * p4) * 2; \
        _Pragma("unroll") for (int kk = 0; kk < 4; ++kk) { const int kbase = 32 * (kk >> 1) + 16 * (kk & 1); \
            _Pragma("unroll") for (int tt = 0; tt < DVT; ++tt) { \
                const s16x4 lo = tr_read(vb + kbase * GEO::VP + tt * 64), hi = tr_read(vb + (kbase + 8) * GEO::VP + tt * 64); \
                acc[tt] = MFMA32(cat8(lo, hi), pf[kk], acc[tt]); } } } while (0)
    { u32x4 kregB, vregB[DVT / 2];
      A_GLOAD(0, kregA, vregA); A_GLOAD(1, kregB, vregB); A_LSTORE(0, kregA, vregA); A_LSTORE(1, kregB, vregB); }
    __syncthreads();
    const int ns = nt >> 1;
    for (int sg = 0; sg < ns; ++sg) {
        const int sb = (sg & 1) * 2;
        if (sg + 1 < ns) A_GLOAD(2 * sg + 2, kregA, vregA);
        A_TILE(2 * sg, sb);
        if (sg + 1 < ns) { A_LSTORE((sb ^ 2), kregA, vregA); A_GLOAD(2 * sg + 3, kregA, vregA); }
        A_TILE(2 * sg + 1, sb + 1);
        if (sg + 1 < ns) A_LSTORE((sb ^ 2) + 1, kregA, vregA);
        __syncthreads();
    }
#undef A_TILE
    lsum = swp_sum(lsum);
#undef A_ROWBASE
#undef A_GLOAD
#undef A_LSTORE
}

DI void attn_phase(const Ctx& F, int l) {
    PHASE_IDS
    const int i2 = l >> 1; const bf16_t* P = (const bf16_t*)(F.ws + WS_BIG); bf16_t* O = (bf16_t*)(F.ws + WS_H);
    const int lane = LANE, l31 = lane & 31, h = lane >> 5;
    const float lam_init = 0.8f - 0.6f * expf(-0.3f * (float)l);
    float lam;
    { const float* lv = F.in[I_DLAM] + i2 * 256; const float a = wave_sum(lv[lane] * lv[64 + lane]), bsum = wave_sum(lv[128 + lane] * lv[192 + lane]); lam = expf(a) - expf(bsum) + lam_init; }
    constexpr int NU = 1024 + 2048 + 128 + 256;
    const int vcu = (F.G % 8 == 0) ? ((int)blockIdx.x % 8) * (F.G / 8) + (int)blockIdx.x / 8 : (int)blockIdx.x;
    for (int u = vcu; u < NU; u += F.G) {
        int b, hd, qb; bool diff, ctxq;
        if (u < 1024) { diff = true; ctxq = false; b = u >> 5; hd = (u >> 3) & 3; qb = u & 7; }
        else if (u < 3072) { const int v = u - 1024; diff = false; ctxq = false; b = v >> 6; hd = (v >> 3) & 7; qb = v & 7; }
        else if (u < 3200) { const int v = u - 3072; diff = true; ctxq = true; b = v >> 2; hd = v & 3; qb = 0; }
        else { const int v = u - 3200; diff = false; ctxq = true; b = v >> 3; hd = v & 7; qb = 0; }
        const int qrow = (ctxq ? T_LAT + b * CTXL : b * SEQ + qb * 256) + F.wave * 32 + l31;
        if (diff) {
            f32x16 a1[4], a2[4]; float l1, l2;
            attn_pass<4>(a1, l1, F, P, b, ctxq, qrow, hd * 128, 512 + hd * 128, 1024 + hd * 128, nullptr);
            attn_pass<4>(a2, l2, F, P, b, ctxq, qrow, hd * 128 + 64, 512 + hd * 128 + 64, 1024 + hd * 128, nullptr);
            const float i1 = 1.0f / l1, i2s = lam / l2; float ss = 0.f;
#pragma unroll
            for (int t = 0; t < 4; ++t)
#pragma unroll
                for (int r = 0; r < 16; ++r) { const float o = a1[t][r] * i1 - a2[t][r] * i2s; a1[t][r] = o; ss += o * o; }
            ss = swp_sum(ss);
            const float rs = rsqrtf(ss * (1.0f / 128.0f) + RMS_EPS) * (1.0f - lam_init);
            const float* sg = F.in[I_SUBLN] + i2 * 128;
            bf16_t* orow = O + (size_t)qrow * DM + hd * 128;
#pragma unroll
            for (int t = 0; t < 4; ++t)
#pragma unroll
                for (int g = 0; g < 4; ++g) { const int dv = t * 32 + 8 * g + 4 * h; const f32x4 gg = *(const f32x4*)(sg + dv);
                    u32x2 w; w.x = cvt_pk_bf16(a1[t][4 * g] * rs * gg[0], a1[t][4 * g + 1] * rs * gg[1]); w.y = cvt_pk_bf16(a1[t][4 * g + 2] * rs * gg[2], a1[t][4 * g + 3] * rs * gg[3]);
                    *(u32x2*)(orow + dv) = w; }
        } else {
            f32x16 a1[2]; float l1;
            attn_pass<2>(a1, l1, F, P, b, ctxq, qrow, 1536 + hd * 64, 2048 + (hd >> 2) * 64, 2176 + (hd >> 2) * 64, F.in[I_QKG] + (i2 * 2 + 0) * 64);
            const float i1 = 1.0f / l1;
            bf16_t* orow = O + (size_t)qrow * DM + 512 + hd * 64;
#pragma unroll
            for (int t = 0; t < 2; ++t)
#pragma unroll
                for (int g = 0; g < 4; ++g) { const int dv = t * 32 + 8 * g + 4 * h;
                    u32x2 w; w.x = cvt_pk_bf16(a1[t][4 * g] * i1, a1[t][4 * g + 1] * i1); w.y = cvt_pk_bf16(a1[t][4 * g + 2] * i1, a1[t][4 * g + 3] * i1);
                    *(u32x2*)(orow + dv) = w; }
        }
    }
}
constexpr int GP = 272;
constexpr int GU_Q = 0, GU_K = 64 * GP, GU_V = 2 * 64 * GP, GU_M = 3 * 64 * GP, GU_ATT = 4 * 64 * GP, GU_SC = GU_ATT + 6144, GU_M10 = GU_SC + 1024, GU_BYTES = 80896;
DI f32x16 tile_nt(const LAS unsigned char* A, const LAS unsigned char* B, int l31, int h) {
    f32x16 c;
#pragma unroll
    for (int r = 0; r < 16; ++r) c[r] = 0.f;
    const LAS unsigned char* ap = A + l31 * GP + h * 16; const LAS unsigned char* bp = B + l31 * GP + h * 16;
#pragma unroll
    for (int ks = 0; ks < 8; ++ks) c = MFMA32(*(const LAS bf16x8*)(ap + ks * 32), *(const LAS bf16x8*)(bp + ks * 32), c);
    return c;
}
DI float softplus_f(float x) { const float e = __expf(x); const float sm = e * (1.0f - e * (0.5f - e * 0.33333334f)); return x > 20.f ? x : (e < 0.01f ? sm : __logf(1.0f + e)); }

DI void gdn_scan_phase(const Ctx& F, int l) {
    const int i2 = l >> 1;
    const bf16_t* P = (const bf16_t*)(F.ws + WS_BIG);
    const float* convw = F.in[I_GCONV] + (size_t)i2 * 4 * 3072;
    const int w4 = F.wave & 3, ub = F.wave >> 2;
    const int e0 = 32 * w4;
    for (int u0 = 2 * blockIdx.x; u0 < 512; u0 += 2 * F.G) {
        const int u = u0 + ub, b = u >> 4, hd = (u >> 1) & 7, dir = u & 1;
        bf16_t* Od = (bf16_t*)(F.ws + (dir ? WS_Y : WS_H));
        const float nalog = __uint_as_float(__builtin_amdgcn_readfirstlane(__float_as_uint(-__expf(F.in[I_GALOG][i2 * 16 + dir * 8 + hd])))), dtb = __uint_as_float(__builtin_amdgcn_readfirstlane(__float_as_uint(F.in[I_GDT][i2 * 16 + dir * 8 + hd])));
        f32x16 S[4];
#pragma unroll
        for (int t = 0; t < 4; ++t)
#pragma unroll
            for (int r = 0; r < 16; ++r) S[t][r] = 0.f;
        for (int step = 0; step < 36; ++step) {
            const bool isctx = step < 4; const int cidx = dir ? (isctx ? 3 - step : 35 - step) : (isctx ? step : step - 4);
            const int seq0 = isctx ? T_LAT + b * CTXL : b * SEQ, L = isctx ? CTXL : SEQ, t0 = 64 * cidx;
            const int lane = get_lane(); const int ut = (F.wave & 3) * 64 + lane;
            const int l31 = lane & 31, h = lane >> 5, q4 = (lane & 15) >> 2, p4 = lane & 3, blk = (lane >> 4) & 1;
            int zs; asm volatile("s_mov_b32 %0, 0" : "=s"(zs));
            LAS unsigned char* U = F.lds + ub * GU_BYTES + zs;
            LAS float* SC = (LAS float*)(U + GU_SC);
            const LAS float* SCh = SC + 4 * h + zs;
#ifndef GDN_NOSTAGE
            unsigned pf0 = 0u, pf1 = 0u;
            {
                const int seg = ut >> 4, cg8 = ut & 15;
                const float* cwl = convw + zs;
                const bf16_t* pbase = P + (size_t)seq0 * GDN_W + hd * 128 + cg8 * 8;
                u32x4 rawA[7], rawB[7];
#define GS_LOAD(raw, MAT) do { _Pragma("unroll") for (int rr = 0; rr < 7; ++rr) { const int ts = t0 + 4 * seg - 2 + rr; u32x4 w_ = {0u, 0u, 0u, 0u}; \
                    if (ts >= 0 && ts < L) w_ = *(const u32x4*)(pbase + (size_t)ts * GDN_W + (MAT) * 1024); raw[rr] = w_; } } while (0)
#define GS_PROC(raw, MAT) do { const int col0 = (MAT) * 1024 + hd * 128 + cg8 * 8; float o[4][8]; \
                    _Pragma("unroll") for (int a = 0; a < 4; ++a) _Pragma("unroll") for (int c = 0; c < 8; ++c) o[a][c] = 0.f; \
                    _Pragma("unroll") for (int j = 0; j < 4; ++j) { const f32x4 wa = *(const f32x4*)(cwl + j * 3072 + col0), wb = *(const f32x4*)(cwl + j * 3072 + col0 + 4); \
                        _Pragma("unroll") for (int a = 0; a < 4; ++a) { const u32x4 w_ = raw[a + j]; \
                            o[a][0] += wa[0] * bflo(w_.x); o[a][1] += wa[1] * bfhi(w_.x); o[a][2] += wa[2] * bflo(w_.y); o[a][3] += wa[3] * bfhi(w_.y); \
                            o[a][4] += wb[0] * bflo(w_.z); o[a][5] += wb[1] * bfhi(w_.z); o[a][6] += wb[2] * bflo(w_.w); o[a][7] += wb[3] * bfhi(w_.w); } } \
                    _Pragma("unroll") for (int a = 0; a < 4; ++a) { float ss = 0.f; \
                        _Pragma("unroll") for (int c = 0; c < 8; ++c) { o[a][c] = silu_f(o[a][c]); ss += o[a][c] * o[a][c]; } \
                        float sc = 1.0f; \
                        if ((MAT) < 2) { ss += shx<1>(ss); ss += shx<2>(ss); ss += shx<4>(ss); ss += shx<8>(ss); sc = rsqrtf(ss + 1e-6f) * ((MAT) == 0 ? 0.08838834764831845f : 1.0f); } \
                        const int tk = 4 * seg + a, row = dir ? 63 - tk : tk; \
                        u32x4 w; w.x = cvt_pk_bf16(o[a][0] * sc, o[a][1] * sc); w.y = cvt_pk_bf16(o[a][2] * sc, o[a][3] * sc); w.z = cvt_pk_bf16(o[a][4] * sc, o[a][5] * sc); w.w = cvt_pk_bf16(o[a][6] * sc, o[a][7] * sc); \
                        *(LAS u32x4*)(U + (MAT) * 64 * GP + row * GP + cg8 * 16) = w; } } while (0)
                bf16_t av_r = 0, bv_r = 0;
                if (w4 == 0) { const int tk = dir ? 63 - lane : lane; const bf16_t* prow = P + (size_t)(seq0 + t0 + tk) * GDN_W + 4096 + dir * 8 + hd; av_r = prow[0]; bv_r = prow[16]; }
                GS_LOAD(rawA, 0); GS_LOAD(rawB, 1);
                GS_PROC(rawA, 0);
                GS_LOAD(rawA, 2);
                GS_PROC(rawB, 1);
                GS_PROC(rawA, 2);
#undef GS_LOAD
#undef GS_PROC
                if (w4 == 0) {
                    const float av = bf2f(av_r), bv = bf2f(bv_r);
                    float g = nalog * softplus_f(av + dtb);
#pragma unroll
                    for (int off = 1; off < 64; off <<= 1) { const float t_ = __int_as_float(__builtin_amdgcn_ds_bpermute((lane - off) << 2, __float_as_int(g))); if (lane >= off) g += t_; }
                    const float glast = __int_as_float(__builtin_amdgcn_readlane(__float_as_int(g), 63));
                    SC[lane] = g; SC[64 + lane] = 1.0f / (1.0f + __expf(-bv)); SC[128 + lane] = __expf(g); SC[192 + lane] = __expf(glast - g);
                }
                if (step + 1 < 36) {
                    const int st1 = step + 1; const bool ic1 = st1 < 4; const int ci1 = dir ? (ic1 ? 3 - st1 : 35 - st1) : (ic1 ? st1 : st1 - 4);
                    const int sq1 = ic1 ? T_LAT + b * CTXL : b * SEQ, L1 = ic1 ? CTXL : SEQ, t1 = 64 * ci1;
                    const int li0 = ut, li1 = ut + 256;
                    { const int row = li0 / 6, part = li0 % 6, ts = t1 - 2 + row; if (ts >= 0 && ts < L1) pf0 = *(const unsigned*)(P + (size_t)(sq1 + ts) * GDN_W + (part >> 1) * 1024 + hd * 128 + (part & 1) * 64); }
                    if (li1 < 402) { const int row = li1 / 6, part = li1 % 6, ts = t1 - 2 + row; if (ts >= 0 && ts < L1) pf1 = *(const unsigned*)(P + (size_t)(sq1 + ts) * GDN_W + (part >> 1) * 1024 + hd * 128 + (part & 1) * 64); }
                }
            }
#endif
            __syncthreads();
#ifndef GDN_NOTILES
            {
                const LAS unsigned char* Qm = U + GU_Q; const LAS unsigned char* Km = U + GU_K;
                if (w4 < 3) {
                    const int jt = (w4 == 2) ? 1 : 0, it = (w4 == 0) ? 0 : 1;
                    f32x16 c = tile_nt(Km + 32 * jt * GP, Qm + 32 * it * GP, l31, h);
                    const int i = 32 * it + l31; const float gi = SC[i]; const int im = i - 4 * h + zs - 32 * jt;
#pragma unroll
                    for (int r = 0; r < 16; ++r) { const int c0 = (r & 3) + 8 * (r >> 2); const float ar = fminf(gi - SCh[32 * jt + c0], 0.f); c[r] = (c0 <= im) ? c[r] * __expf(ar) : 0.f; }
                    *(LAS bf16x8*)(U + GU_ATT + ((w4 * 2 + 0) * 64 + lane) * 16) = pack_step<0>(c);
                    *(LAS bf16x8*)(U + GU_ATT + ((w4 * 2 + 1) * 64 + lane) * 16) = pack_step<1>(c);
                }
                if (w4 == 0) {
                    f32x16 c = tile_nt(Km, Km + 32 * GP, l31, h);
                    const int i = 32 + l31; const float gi = SC[i], bi = SC[64 + i];
#pragma unroll
                    for (int r = 0; r < 16; ++r) { const int c0 = (r & 3) + 8 * (r >> 2); const float ar = fminf(gi - SCh[c0], 0.f); c[r] = bi * c[r] * __expf(ar); }
                    *(LAS bf16x8*)(U + GU_M10 + (0 * 64 + lane) * 16) = pack_step<0>(c);
                    *(LAS bf16x8*)(U + GU_M10 + (1 * 64 + lane) * 16) = pack_step<1>(c);
                }
                if (w4 == 1 || w4 == 3) {
                    const int ti = (w4 == 3) ? 0 : 1, tj = ti;
                    f32x16 c = tile_nt(Km + 32 * ti * GP, Km + 32 * tj * GP, l31, h);
                    const int j = 32 * tj + l31; const float gj = SC[j]; const int jm = j - 4 * h + zs - 32 * ti;
                    LAS unsigned char* mb = U + GU_M + (32 * ti + 4 * h) * GP + j * 4 + zs;
#pragma unroll
                    for (int r = 0; r < 16; ++r) { const int c0 = (r & 3) + 8 * (r >> 2); const float ar = fminf(SCh[32 * ti + c0] - gj, 0.f); const float mv = (c0 > jm) ? SCh[64 + 32 * ti + c0] * c[r] * __expf(ar) : 0.f;
                        *(LAS float*)(mb + c0 * GP) = mv; }
                    { const int i = 32 * ti + l31; const float gi = SC[i], bi = SC[64 + i]; f32x16 cc;
#pragma unroll
                      for (int r = 0; r < 16; ++r) { const int c0 = (r & 3) + 8 * (r >> 2); const float ar = fminf(gi - SCh[32 * ti + c0], 0.f); cc[r] = (r < 8 && l31 >= 16) ? bi * c[r] * __expf(ar) : 0.f; }
                      *(LAS bf16x8*)(U + GU_M10 + ((2 + ti) * 64 + lane) * 16) = pack_step<0>(cc); }
                }
            }
#endif
            __syncthreads();
            __builtin_amdgcn_sched_barrier(0);
            f32x16 R[2];
#pragma unroll
            for (int t = 0; t < 2; ++t)
#pragma unroll
                for (int r = 0; r < 16; ++r) R[t][r] = 0.f;
#define GD_KS(DT, SS) do { const bf16x8 sf = pack_step<SS>(S[DT]); const int dcol = (32 * (DT) + 16 * (SS) + 4 * h) * 2; \
                _Pragma("unroll") for (int it = 0; it < 2; ++it) { const LAS unsigned char* rp = U + (32 * it + l31) * GP + dcol; \
                    const bf16x8 ak = cat8(*(const LAS s16x4*)(rp + GU_K), *(const LAS s16x4*)(rp + GU_K + 16)); \
                    R[it] = MFMA32(ak, sf, R[it]); } } while (0)
            GD_KS(0, 0); GD_KS(0, 1); GD_KS(1, 0); GD_KS(1, 1); GD_KS(2, 0); GD_KS(2, 1); GD_KS(3, 0); GD_KS(3, 1);
#undef GD_KS
            __builtin_amdgcn_sched_barrier(0);
            f32x16 X[2];
#pragma unroll
            for (int t = 0; t < 2; ++t)
#pragma unroll
                for (int r = 0; r < 16; ++r) { const int c0 = 32 * t + (r & 3) + 8 * (r >> 2); const float vv = bf2f(*(const LAS bf16_t*)(U + GU_V + 4 * h * GP + (e0 + l31) * 2 + zs + c0 * GP)); const float eg = SCh[128 + c0];
                    X[t][r] = SCh[64 + c0] * (vv - eg * R[t][r]); }
#ifndef GDN_NOSTAGE
            asm volatile("" :: "v"(pf0), "v"(pf1));
#endif
            asm volatile("" : "+v"(X[0]), "+v"(X[1]));
            __builtin_amdgcn_sched_barrier(0);
#ifndef GDN_NOSOLVE
            {
                const LAS unsigned char* Mh = U + GU_M + 4 * h * GP;
                float xs[2][16];
#pragma unroll
                for (int t_ = 0; t_ < 2; ++t_)
#pragma unroll
                    for (int r_ = 0; r_ < 16; ++r_) xs[t_][r_] = X[t_][r_];
                int zdep = 0;
#pragma unroll
                for (int G = 0; G < 16; ++G) {
                    const int t = G >> 3, rb = 4 * ((G >> 1) & 3), hG = G & 1, i0 = 4 * G;
                    {
                        const bool own = (h == hG);
                        const LAS unsigned char* mp = U + GU_M + i0 * GP + i0 * 4 + zdep;
                        const float m10 = *(const LAS float*)(mp + GP); const f32x2 m2 = *(const LAS f32x2*)(mp + 2 * GP); const f32x4 m3 = *(const LAS f32x4*)(mp + 3 * GP);
                        const float n1 = xs[t][rb + 1] - m10 * xs[t][rb]; xs[t][rb + 1] = own ? n1 : xs[t][rb + 1];
                        const float n2 = xs[t][rb + 2] - (m2[0] * xs[t][rb] + m2[1] * xs[t][rb + 1]); xs[t][rb + 2] = own ? n2 : xs[t][rb + 2];
                        const float n3 = xs[t][rb + 3] - (m3[0] * xs[t][rb] + m3[1] * xs[t][rb + 1] + m3[2] * xs[t][rb + 2]); xs[t][rb + 3] = own ? n3 : xs[t][rb + 3];
                    }
                    __builtin_amdgcn_sched_barrier(0);
                    float v0 = xs[t][rb], v1 = xs[t][rb + 1], v2 = xs[t][rb + 2], v3 = xs[t][rb + 3];
                    const float o0 = swp_other(v0, h), o1 = swp_other(v1, h), o2 = swp_other(v2, h), o3 = swp_other(v3, h);
                    v0 = (h != hG) ? o0 : v0; v1 = (h != hG) ? o1 : v1; v2 = (h != hG) ? o2 : v2; v3 = (h != hG) ? o3 : v3;
                    asm volatile("v_and_b32 %0, 0, %1" : "=v"(zdep) : "v"(v3));
#pragma unroll
                    for (int tt = 0; tt < 2; ++tt)
#pragma unroll
                        for (int rg = 0; rg < 4; ++rg) {
                            const int Gb = 8 * tt + 2 * rg;
                            if (Gb >= G && ((Gb >> 2) == (G >> 2))) {
                                const LAS unsigned char* Mz = Mh + zdep;
                                const bool upd = (Gb > G) || (h == 1);
#pragma unroll
                                for (int a = 0; a < 4; ++a) { const f32x4 mm = *(const LAS f32x4*)(Mz + (32 * tt + 8 * rg + a) * GP + i0 * 4);
                                    const float nv = xs[tt][4 * rg + a] - ((mm[0] * v0 + mm[1] * v1) + (mm[2] * v2 + mm[3] * v3)); xs[tt][4 * rg + a] = upd ? nv : xs[tt][4 * rg + a]; }
                                if (rg == 3) asm volatile("v_and_b32 %0, 0, %1" : "=v"(zdep) : "v"(xs[tt][15]), "v"(xs[tt][14]), "v"(xs[tt][13]), "v"(xs[tt][12]), "v"(xs[tt][11]), "v"(xs[tt][10]), "v"(xs[tt][9]), "v"(xs[tt][8]), "v"(xs[tt][7]), "v"(xs[tt][6]), "v"(xs[tt][5]), "v"(xs[tt][4]), "v"(xs[tt][3]), "v"(xs[tt][2]), "v"(xs[tt][1]), "v"(xs[tt][0]));
                            }
                        }
                    if (G == 3 || G == 11) {
                        const int tq = G >> 3; f32x16 xb, ab;
#pragma unroll
                        for (int r_ = 0; r_ < 16; ++r_) { xb[r_] = xs[tq][r_]; ab[r_] = 0.f; }
                        ab = MFMA32(*(const LAS bf16x8*)(U + GU_M10 + (2 + tq) * 1024 + lane * 16 + zdep), pack_step<0>(xb), ab);
#pragma unroll
                        for (int r_ = 0; r_ < 16; ++r_) xs[tq][r_] -= ab[r_];
                    }
                    if (G == 7) {
                        f32x16 x0, a10;
#pragma unroll
                        for (int r_ = 0; r_ < 16; ++r_) { x0[r_] = xs[0][r_]; a10[r_] = 0.f; }
                        const LAS unsigned char* mf = U + GU_M10 + lane * 16 + zdep;
                        a10 = MFMA32(*(const LAS bf16x8*)(mf), pack_step<0>(x0), a10);
                        a10 = MFMA32(*(const LAS bf16x8*)(mf + 1024), pack_step<1>(x0), a10);
#pragma unroll
                        for (int r_ = 0; r_ < 16; ++r_) xs[1][r_] -= a10[r_];
                    }
                }
#pragma unroll
                for (int t_ = 0; t_ < 2; ++t_)
#pragma unroll
                    for (int r_ = 0; r_ < 16; ++r_) X[t_][r_] = xs[t_][r_];
            }
#endif
            __builtin_amdgcn_sched_barrier(0);
#ifndef GDN_NOPOST
            {
                int zs2; asm volatile("v_and_b32 %0, 0, %1" : "=v"(zs2) : "v"(X[1][15]));
                const LAS float* SCh2 = (const LAS float*)((const LAS unsigned char*)(SC + 4 * h) + zs2);
                const LAS unsigned char* U2 = U + zs2;
                asm volatile("" : "+v"(S[0]), "+v"(S[1]), "+v"(S[2]), "+v"(S[3]));
                f32x16 Oq[2];
#pragma unroll
                for (int t = 0; t < 2; ++t)
#pragma unroll
                    for (int r = 0; r < 16; ++r) Oq[t][r] = 0.f;
#define GD_QS(DT, SS) do { const bf16x8 sf = pack_step<SS>(S[DT]); const int dcol = (32 * (DT) + 16 * (SS) + 4 * h) * 2; \
                _Pragma("unroll") for (int it = 0; it < 2; ++it) { const LAS unsigned char* rp = U2 + (32 * it + l31) * GP + dcol; \
                    const bf16x8 aq = cat8(*(const LAS s16x4*)(rp + GU_Q), *(const LAS s16x4*)(rp + GU_Q + 16)); \
                    Oq[it] = MFMA32(aq, sf, Oq[it]); } } while (0)
                GD_QS(0, 0); GD_QS(0, 1); GD_QS(1, 0); GD_QS(1, 1); GD_QS(2, 0); GD_QS(2, 1); GD_QS(3, 0); GD_QS(3, 1);
#undef GD_QS
#pragma unroll
                for (int t = 0; t < 2; ++t)
#pragma unroll
                    for (int r = 0; r < 16; ++r) Oq[t][r] *= SCh2[128 + 32 * t + (r & 3) + 8 * (r >> 2)];
                const bf16x8 vf0 = pack_step<0>(X[0]), vf1 = pack_step<1>(X[0]), vf2 = pack_step<0>(X[1]), vf3 = pack_step<1>(X[1]);
                const LAS unsigned char* at = U2 + GU_ATT + lane * 16;
                Oq[0] = MFMA32(*(const LAS bf16x8*)(at + 0 * 1024), vf0, Oq[0]); Oq[0] = MFMA32(*(const LAS bf16x8*)(at + 1 * 1024), vf1, Oq[0]);
                Oq[1] = MFMA32(*(const LAS bf16x8*)(at + 2 * 1024), vf0, Oq[1]); Oq[1] = MFMA32(*(const LAS bf16x8*)(at + 3 * 1024), vf1, Oq[1]);
                Oq[1] = MFMA32(*(const LAS bf16x8*)(at + 4 * 1024), vf2, Oq[1]); Oq[1] = MFMA32(*(const LAS bf16x8*)(at + 5 * 1024), vf3, Oq[1]);
                const int sdm = dir ? -DM : DM;
                bf16_t* ob = Od + (size_t)(seq0 + t0 + (dir ? 63 - 4 * h : 4 * h)) * DM + hd * 128 + e0 + l31;
#pragma unroll
                for (int t = 0; t < 2; ++t)
#pragma unroll
                    for (int rg = 0; rg < 4; ++rg) { bf16_t* pg = ob + (32 * t + 8 * rg) * sdm;
#pragma unroll
                        for (int a = 0; a < 4; ++a) __builtin_nontemporal_store(f2bf(Oq[t][4 * rg + a]), pg + a * sdm); }
            }
            __builtin_amdgcn_sched_barrier(0);
            {
                int zs3; asm volatile("v_and_b32 %0, 0, %1" : "=v"(zs3) : "v"(X[0][0]));
                const LAS float* SCh3 = (const LAS float*)((const LAS unsigned char*)(SC + 4 * h) + zs3);
                const float gl = SC[128 + 63];
#pragma unroll
                for (int t = 0; t < 4; ++t)
#pragma unroll
                    for (int r = 0; r < 16; ++r) S[t][r] *= gl;
#pragma unroll
                for (int t = 0; t < 2; ++t)
#pragma unroll
                    for (int r = 0; r < 16; ++r) X[t][r] *= SCh3[192 + 32 * t + (r & 3) + 8 * (r >> 2)];
                const bf16x8 vf[4] = {pack_step<0>(X[0]), pack_step<1>(X[0]), pack_step<0>(X[1]), pack_step<1>(X[1])};
                const LAS unsigned char* kt = U + GU_K + (4 * h + q4) * GP + (16 * blk + 4 * p4) * 2 + zs3;
#pragma unroll
                for (int jk = 0; jk < 4; ++jk) {
                    const int ib = 32 * (jk >> 1) + 16 * (jk & 1);
#pragma unroll
                    for (int dt = 0; dt < 4; ++dt) { const s16x4 lo = tr_read(kt + ib * GP + dt * 64), hi = tr_read(kt + (ib + 8) * GP + dt * 64); S[dt] = MFMA32(cat8(lo, hi), vf[jk], S[dt]); }
                }
            }
#else
            S[0][0] += X[0][0] + X[1][15]; S[1][3] += X[0][7];
#endif
            __syncthreads();
        }
    }
}

DI void gdn_readout_phase(const Ctx& F, int l, int Mrows) {
    PHASE_IDS
    const int i2 = l >> 1; const bf16_t* P = (const bf16_t*)(F.ws + WS_BIG); bf16_t* Of = (bf16_t*)(F.ws + WS_H); const bf16_t* Ob = (const bf16_t*)(F.ws + WS_Y);
    const f32x4 gg = *(const f32x4*)(F.in[I_GNORM] + i2 * 128 + ((4 * LANE) & 127));
    const int rpw = (Mrows + F.ngw - 1) / F.ngw, mb = F.gw * rpw, me = (mb + rpw < Mrows) ? mb + rpw : Mrows;
    if (mb >= me) return;
    u32x2 an[4], bn[4], zn[4];
#define RO_FETCH(m_) do { const u32x2* ofp_ = (const u32x2*)(Of + (size_t)(m_) * DM) + LANE; const u32x2* obp_ = (const u32x2*)(Ob + (size_t)(m_) * DM) + LANE; const u32x2* zp_ = (const u32x2*)(P + (size_t)(m_) * GDN_W + 3072) + LANE; \
        _Pragma("unroll") for (int j = 0; j < 4; ++j) { an[j] = __builtin_nontemporal_load(ofp_ + 64 * j); bn[j] = __builtin_nontemporal_load(obp_ + 64 * j); zn[j] = __builtin_nontemporal_load(zp_ + 64 * j); } } while (0)
    RO_FETCH(mb);
    for (int m = mb; m < me; ++m) {
        u32x2 av[4], bv[4], zv[4];
#pragma unroll
        for (int j = 0; j < 4; ++j) { av[j] = an[j]; bv[j] = bn[j]; zv[j] = zn[j]; }
        if (m + 1 < me) RO_FETCH(m + 1);
        u32x2* ofp = (u32x2*)(Of + (size_t)m * DM) + LANE;
#pragma unroll
        for (int j = 0; j < 4; ++j) {
            const u32x2 a = av[j], bq = bv[j], z = zv[j];
            f32x4 o = (f32x4){bflo(a.x) + bflo(bq.x), bfhi(a.x) + bfhi(bq.x), bflo(a.y) + bflo(bq.y), bfhi(a.y) + bfhi(bq.y)};
            float ss = (o[0] * o[0] + o[1] * o[1]) + (o[2] * o[2] + o[3] * o[3]);
            ss += shx<1>(ss); ss += shx<2>(ss); ss += shx<4>(ss); ss += shx<8>(ss); ss += shx<16>(ss);
            const float rs = rsqrtf(ss * (1.0f / 128.0f) + RMS_EPS);
            const f32x4 zz = (f32x4){bflo(z.x), bfhi(z.x), bflo(z.y), bfhi(z.y)};
            u32x2 w; w.x = cvt_pk_bf16(o[0] * rs * gg[0] * silu_f(zz[0]), o[1] * rs * gg[1] * silu_f(zz[1])); w.y = cvt_pk_bf16(o[2] * rs * gg[2] * silu_f(zz[2]), o[3] * rs * gg[3] * silu_f(zz[3]));
            ofp[64 * j] = w;
        }
    }
#undef RO_FETCH
}
#define XB_TMO      128
#define XB_XCNT(j)  (256  + 64 * (j))
#define XB_XSUB(j)  (1280 + 64 * (j))
#define XB_XGEN(j)  (2304 + 64 * (j))
#define XB_TOP      3328
#define XB_TOPGEN   3392
#define XCD_BAR_WORDS 3456
#define XB_SPIN_CAP (1u << 24)

__device__ __forceinline__ unsigned xb_ld(unsigned* p)              { return __hip_atomic_load(p, __ATOMIC_RELAXED, __HIP_MEMORY_SCOPE_AGENT); }
__device__ __forceinline__ unsigned xb_add(unsigned* p, unsigned v) { return __hip_atomic_fetch_add(p, v, __ATOMIC_RELAXED, __HIP_MEMORY_SCOPE_AGENT); }
__device__ __forceinline__ unsigned xb_xcc_id() { return (unsigned)__builtin_amdgcn_s_getreg((3 << 11) | 20) & 0xFu; }
#define XB_SPIN(cond, bar) do { unsigned _sp = 0; while (cond) { __builtin_amdgcn_s_sleep(1); \
    if ((++_sp & 255u) == 0u) { if (xb_ld(&(bar)[XB_TMO])) break; if (_sp > XB_SPIN_CAP) { atomicAdd(&(bar)[XB_TMO], 1u); break; } } } } while (0)

struct XcdBarrier {
    unsigned* bar; unsigned x;
    volatile LAS unsigned* st;
};

__device__ __forceinline__ XcdBarrier xcd_barrier_post(unsigned* bar, volatile LAS unsigned* st) {
    XcdBarrier b; b.bar = bar; b.x = xb_xcc_id(); b.st = st;
    if (threadIdx.x == 0) (void)xb_add(&bar[XB_XCNT(b.x)], 1u);
    return b;
}
__device__ __forceinline__ void xcd_barrier_complete(unsigned* bar, unsigned x, unsigned& nloc, unsigned& nx) {
    const unsigned G = gridDim.x * gridDim.y * gridDim.z;
    unsigned sum, cnt, mine, sp = 0u;
    for (;;) {
        sum = 0u; cnt = 0u; mine = 0u;
#pragma unroll
        for (unsigned j = 0; j < 16; ++j) { const unsigned c = xb_ld(&bar[XB_XCNT(j)]); sum += c; cnt += (c > 0u) ? 1u : 0u; mine = (j == x) ? c : mine; }
        if (sum == G) break;
        __builtin_amdgcn_s_sleep(1);
        if ((++sp & 255u) == 0u) { if (xb_ld(&bar[XB_TMO])) break; if (sp > XB_SPIN_CAP) { atomicAdd(&bar[XB_TMO], 1u); break; } }
    }
    nloc = mine > 0u ? mine : 1u; nx = cnt > 0u ? cnt : 1u;
}

__device__ __forceinline__ void xcd_barrier(const XcdBarrier& b) {
    asm volatile("s_waitcnt vmcnt(0)" ::: "memory");
    __syncthreads();
    if (threadIdx.x == 0) {
        unsigned* bar = b.bar;
        __builtin_amdgcn_s_waitcnt(0);
        unsigned nloc = b.st[0], nx = b.st[1];
        if (nloc == 0u) { xcd_barrier_complete(bar, b.x, nloc, nx); b.st[0] = nloc; b.st[1] = nx; }
        const unsigned old = xb_add(&bar[XB_XSUB(b.x)], 1u);
        const unsigned gen = old / nloc;
        if (old + 1u == (gen + 1u) * nloc) {
            __builtin_amdgcn_fence(__ATOMIC_RELEASE, "agent");
            asm volatile("s_waitcnt vmcnt(0)" ::: "memory");
            const unsigned og = xb_add(&bar[XB_TOP], 1u);
            const unsigned tg = og / nx;
            if (og + 1u == (tg + 1u) * nx) xb_add(&bar[XB_TOPGEN], 1u);
            else XB_SPIN(xb_ld(&bar[XB_TOPGEN]) == tg, bar);
            __builtin_amdgcn_fence(__ATOMIC_ACQUIRE, "agent");
            xb_add(&bar[XB_XGEN(b.x)], 1u);
            asm volatile("s_waitcnt vmcnt(0)" ::: "memory");
        } else {
            XB_SPIN(xb_ld(&bar[XB_XGEN(b.x)]) == gen, bar);
            __builtin_amdgcn_fence(__ATOMIC_ACQUIRE, "agent");
            asm volatile("s_waitcnt vmcnt(0)" ::: "memory");
        }
    }
    __syncthreads();
}

template <class Epi> DI void run_gemm(const Ctx& F, const bf16_t* A, const bf16_t* Bt, int M, int N, int K, const Epi& E) {
    pg8::Gemm g{A, Bt, M, N, K}; pg8::StaticOrder S; S.init(M, N, F.G, (int)blockIdx.x);
    pg8::gemm_phase<Epi, pg8::StaticOrder, Epi::ALIGN, true>(F.lds, g, S, E, F.wave);
}
constexpr int N_PHASES = 2 + 8 * 4;
#ifndef ENMASK
#define ENMASK 0xff
#endif
#define EN(k) (((ENMASK) >> (k)) & 1)
#ifndef PROBE_DUP
#define PROBE_DUP 0
#endif
#define DUP(k) ((((PROBE_DUP) >> (k)) & 1) ? 2 : 1)
__global__ void __launch_bounds__(NTHREADS, 2) mk_fwd(Args args) {
    extern __shared__ __attribute__((aligned(16))) unsigned char lds_raw[];
    cg::grid_group grid = cg::this_grid();
    volatile LAS unsigned* bar_st = (volatile LAS unsigned*)((LAS unsigned char*)lds_raw + LDS_BYTES - 16);
    if (threadIdx.x == 0) { bar_st[0] = 0u; bar_st[1] = 0u; }
    __syncthreads();
    XcdBarrier xbar = xcd_barrier_post((unsigned*)(args.ws + WS_BAR), bar_st);
    Ctx F;
    F.in = (const float* const __attribute__((address_space(4)))*)__builtin_amdgcn_kernarg_segment_ptr();
    F.out = args.out; F.ws = args.ws; F.lds = (LAS unsigned char*)lds_raw;
    const int wave0 = __builtin_amdgcn_readfirstlane((int)threadIdx.x >> 6);
    F.wave = 0; F.gw = 0; F.G = gridDim.x; F.ngw = F.G * NWAVES;
    bf16_t *H, *Y, *BIG; const bf16_t *win_t, *wout_t, *wgu_t, *wdn_t;
    for (int ph = args.ph_lo; ph < args.ph_hi; ++ph) {
        {
            unsigned char* ws_o = args.ws; float* out_o = args.out; int wv_o = wave0; asm volatile("" : "+s"(ws_o), "+s"(out_o), "+s"(wv_o));
            F.wave = wv_o; F.gw = blockIdx.x * NWAVES + F.wave; F.ws = ws_o; F.out = out_o;
            H = (bf16_t*)(F.ws + WS_H); Y = (bf16_t*)(F.ws + WS_Y); BIG = (bf16_t*)(F.ws + WS_BIG);
            win_t = (const bf16_t*)(F.ws + WS_WIN); wout_t = (const bf16_t*)(F.ws + WS_WOUT); wgu_t = (const bf16_t*)(F.ws + WS_WGU); wdn_t = (const bf16_t*)(F.ws + WS_WDN);
        }
        if (ph == 0) { for (int rep = 0; rep < DUP(3); ++rep) { if (EN(0)) modvec_phase(F); if (EN(1)) wconv_layer(F, 0); if (rep + 1 < DUP(3)) grid.sync(); } }
        else if (ph == 1) { for (int rep = 0; rep < DUP(4); ++rep) { if (EN(2)) rowwise_phase(F, 0, 0, T_ALL); if (rep + 1 < DUP(4)) grid.sync(); } }
        else {
            const int l = (ph - 2) >> 3, sub = (ph - 2) & 7; const bool odd = l & 1; const int Mr = (l == 3) ? T_LAT : T_ALL;
            int gk = 0, gM = 0, gN = 0, gK = 0, gld = 0; const bf16_t* gA = nullptr; const bf16_t* gB = nullptr; bf16_t* gO = nullptr;
            switch (sub) {
            case 0: gk = 1; gA = H; gB = win_t; gO = BIG; gM = T_ALL; gN = odd ? GDN_W : ATT_W; gK = DM; gld = gN; break;
            case 1: if (odd) { if (EN(6)) for (int rep = 0; rep < DUP(2); ++rep) { gdn_scan_phase(F, l); if (rep + 1 < DUP(2)) grid.sync(); } } else { if (EN(4)) attn_prep_phase(F, l >> 1); } break;
            case 2: if (odd) { if (EN(7)) gdn_readout_phase(F, l, Mr); } else { if (EN(5)) for (int rep = 0; rep < DUP(1); ++rep) { attn_phase(F, l); if (rep + 1 < DUP(1)) grid.sync(); } } break;
            case 3: gk = 1; gA = H; gB = wout_t; gO = Y; gM = Mr; gN = DM; gK = DM; gld = DM; break;
            case 4: if (EN(2)) rowwise_phase(F, 1, l, Mr); break;
            case 5: gk = 2; gA = H; gB = wgu_t; gO = BIG; gM = Mr; gN = 2 * FFH; gK = DM; gld = FFH; break;
            case 6: gk = 1; gA = BIG; gB = wdn_t; gO = Y; gM = Mr; gN = DM; gK = FFH; gld = DM; break;
            default: if (EN(2)) rowwise_phase(F, 2, l, Mr); if (EN(1) && l < 3) wconv_layer(F, l + 1); break;
            }
            if (EN(3)) for (int rep = 0; rep < DUP(0); ++rep) {
                if (gk == 1) { pg8::EpiStore E{gO, gld}; run_gemm(F, gA, gB, gM, gN, gK, E); }
                else if (gk == 2) { pg8::EpiSwiglu E{gO, gld}; run_gemm(F, gA, gB, gM, gN, gK, E); }
                if (rep + 1 < DUP(0)) grid.sync();
            }
        }
        if (ph + 1 < args.ph_hi) { if (ph == args.ph_lo) grid.sync(); else xcd_barrier(xbar); if (DUP(5) == 2) xcd_barrier(xbar); }
    }
}

extern "C" void kernel_launch(void* const* d_in, const int* in_sizes, int n_in, void* d_out, int out_size, void* d_ws, size_t ws_size, hipStream_t stream) {
    static int grid = 0;
    if (grid == 0) {
        if (n_in != 20 || out_size != T_LAT * DM || ws_size < WS_END) { fprintf(stderr, "kernel_launch: unexpected problem shape (n_in %d out %d ws %zu)\n", n_in, out_size, ws_size); grid = -1; return; }
        int dev = 0, cus = 0, per_cu = 0;
        (void)hipGetDevice(&dev); (void)hipDeviceGetAttribute(&cus, hipDeviceAttributeMultiprocessorCount, dev);
        if (hipFuncSetAttribute((const void*)mk_fwd, hipFuncAttributeMaxDynamicSharedMemorySize, LDS_BYTES) != hipSuccess) { fprintf(stderr, "kernel_launch: hipFuncSetAttribute failed\n"); grid = -1; return; }
        if (hipOccupancyMaxActiveBlocksPerMultiprocessor(&per_cu, (const void*)mk_fwd, NTHREADS, LDS_BYTES) != hipSuccess || per_cu < 1) { fprintf(stderr, "kernel_launch: occupancy query says %d\n", per_cu); per_cu = 1; }
        (void)hipGetLastError();
        grid = cus * per_cu;
    }
    if (grid < 0) return;
    if (hipMemsetAsync((char*)d_ws + WS_BAR, 0, XCD_BAR_WORDS * 4, stream) != hipSuccess) { fprintf(stderr, "kernel_launch: memset of the barrier words failed\n"); return; }
    Args a{};
    for (int i = 0; i < 20; ++i) a.in[i] = (const float*)d_in[i];
    a.out = (float*)d_out; a.ws = (unsigned char*)d_ws; a.ph_lo = 0; a.ph_hi = N_PHASES;
    void* kargs[] = {&a};
    hipError_t e = hipLaunchCooperativeKernel((const void*)mk_fwd, dim3(grid), dim3(NTHREADS), kargs, LDS_BYTES, stream);
    if (e != hipSuccess) fprintf(stderr, "cooperative launch failed: %s (grid %d)\n", hipGetErrorString(e), grid);
}
```

```cpp
#include <hip/hip_runtime.h>
#include <hip/hip_cooperative_groups.h>
#include <cstdio>
#include <cstdint>
namespace cg = cooperative_groups;
namespace pg8 {
#define PG8_LAS __attribute__((address_space(3)))
typedef unsigned short bf16_t;
typedef short bf16x8 __attribute__((ext_vector_type(8)));
typedef float f32x4 __attribute__((ext_vector_type(4)));
typedef unsigned u32x4 __attribute__((ext_vector_type(4)));
constexpr int BM = 256, BK = 64, HALF = 128, HTB = HALF * BK * 2  , STAGE_BYTES = 8 * HTB, NXCD = 8, WGM = 8;

__host__ __device__ __forceinline__ int lds_byte(int r, int c) { const int st = (r >> 4) * 2 + (c >> 5), rr = r & 15, cc = c & 31, ob = rr * 64 + cc * 2; return st * 1024 + (ob ^ (((ob >> 9) & 1) << 5)); }
__host__ __device__ __forceinline__ void stage_rc(int b, int& R, int& C) { const int st = b / 1024, sb = b % 1024, swz = sb ^ (((sb >> 9) & 1) << 5); R = (st >> 1) * 16 + swz / 64; C = (st & 1) * 32 + (swz % 64) / 2; }
__host__ __device__ __forceinline__ int perm32(int rho) { const int n = rho >> 4, i = rho & 15; return 8 * (i >> 2) + 4 * n + (i & 3); }

struct Unit { int pm, pn; };
struct Gemm { const bf16_t* A; const bf16_t* Bt; int M, N, K; };

struct StaticOrder {
    int nM, nN, nwg, G, c;
    __host__ __device__ void init(int M, int N, int G_, int c_) { nM = M / BM; nN = N / BM; nwg = nM * nN; G = G_; c = c_; }
    __host__ __device__ bool next(int i, Unit& u) const {
        const long L = (long)i * G + c; if (L >= nwg) return false;
        int wgid = (int)L; { const int q = nwg / NXCD, r = nwg % NXCD, xcd = wgid % NXCD, off = wgid / NXCD; wgid = (xcd < r ? xcd * (q + 1) : r * (q + 1) + (xcd - r) * q) + off; }
        const int nig = WGM * nN, gid = wgid / nig, fm = gid * WGM, gsz = (nM - fm) < WGM ? (nM - fm) : WGM;
        u.pm = fm + ((wgid % nig) % gsz); u.pn = (wgid % nig) / gsz; return true;
    }
    __device__ __forceinline__ void a_ready(const Unit&) const {}
    __device__ __forceinline__ void done(const Unit&) const {}
};

typedef float f32x2 __attribute__((ext_vector_type(2)));
typedef __bf16 bf16x2_t __attribute__((ext_vector_type(2)));
__device__ __forceinline__ unsigned cvt_pk_bf16(float lo, float hi) { f32x2 v = {lo, hi}; bf16x2_t b = __builtin_convertvector(v, bf16x2_t); return __builtin_bit_cast(unsigned, b); }
__device__ __forceinline__ float silu_f(float x) { return x * __builtin_amdgcn_rcpf(1.0f + __expf(-x)); }
__device__ __forceinline__ float lane32_other(float v, int hh) { auto rr = __builtin_amdgcn_permlane32_swap(__builtin_bit_cast(unsigned, v), __builtin_bit_cast(unsigned, v), false, false); return __builtin_bit_cast(float, hh ? rr[0] : rr[1]); }
struct EpiStore {
    static constexpr bool PERM = true, AFTER_DRAIN = false, ALIGN = true;
    bf16_t* O; int ldc; int rope;
    __device__ __forceinline__ void operator()(const f32x4 (&acc)[2][2][4][2], const Unit& u, int wr, int wc, int fr, int fq) const {
        const int row0 = u.pm * BM + wr * 64 + fr; const int col0 = u.pn * BM + wc * 32 + 8 * fq;
        const bool dorope = rope && (u.pn == 2 || u.pn == 3) && (u.pm * BM < 65536);
        float invf[8];
#pragma unroll
        for (int j = 0; j < 8; ++j) invf[j] = __builtin_amdgcn_exp2f(-(float)(2 * (8 * (fq & 1) + j)) * (13.287712379549449f / 32.0f));
        const float sgn = (fq & 2) ? 1.0f : -1.0f;
#pragma unroll
        for (int ai = 0; ai < 2; ++ai)
#pragma unroll
            for (int m = 0; m < 4; ++m) { const int row = row0 + ai * HALF + m * 16; bf16_t* rowp = O + (size_t)row * ldc + col0;
                float cs[8], sn[8];
                if (dorope) { const int t = row & 2047; const float pos = (float)((wc & 1) ? (t & 63) : (t >> 6));
#pragma unroll
                    for (int j = 0; j < 8; ++j) { cs[j] = __cosf(pos * invf[j]); sn[j] = __sinf(pos * invf[j]); } }
#pragma unroll
                for (int bj = 0; bj < 2; ++bj) { f32x4 v0 = acc[ai][bj][m][0], v1 = acc[ai][bj][m][1];
                    if (dorope) {
#pragma unroll
                        for (int j = 0; j < 4; ++j) { const float p0 = lane32_other(v0[j], fq >> 1), p1 = lane32_other(v1[j], fq >> 1);
                            v0[j] = v0[j] * cs[j] + sgn * p0 * sn[j]; v1[j] = v1[j] * cs[4 + j] + sgn * p1 * sn[4 + j]; } }
                    u32x4 w; w.x = cvt_pk_bf16(v0[0], v0[1]); w.y = cvt_pk_bf16(v0[2], v0[3]); w.z = cvt_pk_bf16(v1[0], v1[1]); w.w = cvt_pk_bf16(v1[2], v1[3]);
                    *(u32x4*)(rowp + bj * HALF) = w; } }
    }
};
struct EpiSwiglu {
    static constexpr bool PERM = true, AFTER_DRAIN = false, ALIGN = true;
    bf16_t* O; int ldc;
    __device__ __forceinline__ void operator()(const f32x4 (&acc)[2][2][4][2], const Unit& u, int wr, int wc, int fr, int fq) const {
        const int row0 = u.pm * BM + wr * 64 + fr; const int col0 = u.pn * HALF + wc * 32 + 8 * fq;
#pragma unroll
        for (int ai = 0; ai < 2; ++ai)
#pragma unroll
            for (int m = 0; m < 4; ++m) { bf16_t* rowp = O + (size_t)(row0 + ai * HALF + m * 16) * ldc + col0;
                const f32x4 g0 = acc[ai][0][m][0], g1 = acc[ai][0][m][1], u0 = acc[ai][1][m][0], u1 = acc[ai][1][m][1];
                u32x4 w; w.x = cvt_pk_bf16(silu_f(g0[0]) * u0[0], silu_f(g0[1]) * u0[1]); w.y = cvt_pk_bf16(silu_f(g0[2]) * u0[2], silu_f(g0[3]) * u0[3]);
                w.z = cvt_pk_bf16(silu_f(g1[0]) * u1[0], silu_f(g1[1]) * u1[1]); w.w = cvt_pk_bf16(silu_f(g1[2]) * u1[2], silu_f(g1[3]) * u1[3]);
                __builtin_nontemporal_store(w, (u32x4*)rowp); }
    }
};

template <class Epi, class Sched, bool ALIGN_EPI = false, bool SP2 = false>
__device__ __forceinline__ void gemm_phase(PG8_LAS unsigned char* lds, const Gemm g, const Sched& S, const Epi& E, int wave_id) {
    int lane_; asm volatile("v_mbcnt_lo_u32_b32 %0, -1, 0\n\tv_mbcnt_hi_u32_b32 %0, -1, %0" : "=v"(lane_)); const int tid_ = wave_id * 64 + lane_;
    const int tid = tid_, wid = __builtin_amdgcn_readfirstlane(tid >> 6), lane = tid & 63, wr = wid >> 2, wc = wid & 3, fr = lane & 15, fq = lane >> 4;
    const int K = g.K, nt = K / BK;
    unsigned voffA[2], voffB[2];
#pragma unroll
    for (int i = 0; i < 2; ++i) { int R, C; stage_rc(tid * 16 + i * 8192, R, C); const int Rb = Epi::PERM ? ((R & ~31) + perm32(R & 31)) : R;
        voffA[i] = (unsigned)(R * K + C) * 2u; voffB[i] = (unsigned)(Rb * K + C) * 2u; }
    const size_t kstep = (size_t)(BK * 2);
    const size_t hstep = (size_t)HALF * K * 2;
    const size_t tstep = 2 * hstep;
    const unsigned ldsw = (unsigned)wid * 1024u;
    const int aoff = lds_byte(wr * 64 + fr, fq * 8), boff = lds_byte(wc * 32 + fr, fq * 8);
#define PG8_SA(b, h) (((b) * 2 + (h)) * HTB)
#define PG8_SB(b, h) ((4 + (b) * 2 + (h)) * HTB)
#define PG8_STAGE(bufoff, gbase, voff) do { _Pragma("unroll") for (int _i = 0; _i < 2; ++_i) \
        __builtin_amdgcn_global_load_lds((const unsigned*)((const char*)(gbase) + (voff)[_i]), (PG8_LAS unsigned*)(lds + (bufoff) + ldsw + _i * 8192), 16, 0, 0); } while (0)
#define PG8_LDA(dst, b, h) do { _Pragma("unroll") for (int m = 0; m < 4; ++m) _Pragma("unroll") for (int k = 0; k < 2; ++k) dst[m][k] = *(const PG8_LAS bf16x8*)(lds + PG8_SA(b, h) + aoff + m * 2048 + k * 1024); } while (0)
#define PG8_LDB(dst, b, h) do { _Pragma("unroll") for (int n = 0; n < 2; ++n) _Pragma("unroll") for (int k = 0; k < 2; ++k) dst[n][k] = *(const PG8_LAS bf16x8*)(lds + PG8_SB(b, h) + boff + n * 2048 + k * 1024); } while (0)
#define PG8_MMA(ai, bj, At, Bt) do { __builtin_amdgcn_s_setprio(1); _Pragma("unroll") for (int m = 0; m < 4; ++m) _Pragma("unroll") for (int n = 0; n < 2; ++n) _Pragma("unroll") for (int k = 0; k < 2; ++k) \
        acc[ai][bj][m][n] = __builtin_amdgcn_mfma_f32_16x16x32_bf16(Bt[n][k], At[m][k], acc[ai][bj][m][n], 0, 0, 0); __builtin_amdgcn_s_setprio(0); } while (0)
#define PG8_WAIT_V(n) asm volatile("s_waitcnt vmcnt(" #n ")" ::: "memory")
#define PG8_WAIT_L(n) asm volatile("s_waitcnt lgkmcnt(" #n ")" ::: "memory")
#define PG8_BAR __builtin_amdgcn_s_barrier()
#define PG8_SCHED __builtin_amdgcn_sched_barrier(0)
    Unit cur, nxt; int ui = 0;
    if (!S.next(0, cur)) return;
    f32x4 acc[2][2][4][2];
#pragma unroll
    for (int a = 0; a < 2; ++a)
#pragma unroll
        for (int b = 0; b < 2; ++b)
#pragma unroll
            for (int m = 0; m < 4; ++m)
#pragma unroll
                for (int n = 0; n < 2; ++n) acc[a][b][m][n] = (f32x4){0.f, 0.f, 0.f, 0.f};
    bf16x8 At[4][2], B0[2][2], B1[2][2];
    const char* cA = (const char*)g.A + (size_t)cur.pm * tstep; const char* cB = (const char*)g.Bt + (size_t)cur.pn * tstep;
    S.a_ready(cur);
    if constexpr (SP2) {
        PG8_STAGE(PG8_SB(0, 0), cB, voffB); PG8_STAGE(PG8_SB(0, 1), cB + hstep, voffB); PG8_STAGE(PG8_SA(0, 0), cA, voffA); PG8_STAGE(PG8_SA(0, 1), cA + hstep, voffA);
        if (wr == 1) PG8_BAR;
        PG8_WAIT_V(2); PG8_BAR;
        PG8_STAGE(PG8_SB(1, 0), cB + kstep, voffB); PG8_STAGE(PG8_SA(1, 0), cA + kstep, voffA); PG8_STAGE(PG8_SB(1, 1), cB + hstep + kstep, voffB);
        PG8_WAIT_V(6); PG8_BAR;
    } else {
        PG8_STAGE(PG8_SB(0, 0), cB, voffB); PG8_STAGE(PG8_SA(0, 0), cA, voffA); PG8_STAGE(PG8_SB(0, 1), cB + hstep, voffB); PG8_STAGE(PG8_SA(0, 1), cA + hstep, voffA);
        if (wr == 1) PG8_BAR;
        PG8_WAIT_V(4); PG8_BAR;
        PG8_STAGE(PG8_SB(1, 0), cB + kstep, voffB); PG8_STAGE(PG8_SA(1, 0), cA + kstep, voffA); PG8_STAGE(PG8_SB(1, 1), cB + hstep + kstep, voffB);
        PG8_WAIT_V(6); PG8_BAR;
    }
    for (;;) {
        const bool has_next = S.next(ui + 1, nxt);
        const char* nA = has_next ? (const char*)g.A + (size_t)nxt.pm * tstep : cA; const char* nB = has_next ? (const char*)g.Bt + (size_t)nxt.pn * tstep : cB;
        for (int t = 0; t < nt; t += 2) {
            const bool last = (t == nt - 2);
            const char* a1 = cA + (size_t)(t + 1) * kstep;
            const char* a2 = last ? nA : cA + (size_t)(t + 2) * kstep; const char* b2 = last ? nB : cB + (size_t)(t + 2) * kstep;
            const char* a3 = a2 + kstep; const char* b3 = b2 + kstep;
            if (last && has_next) S.a_ready(nxt);
            if constexpr (SP2) {
            PG8_LDB(B0, 0, 0); PG8_LDB(B1, 0, 1); PG8_SCHED; PG8_LDA(At, 0, 0); PG8_STAGE(PG8_SA(1, 1), a1 + hstep, voffA);
            PG8_WAIT_V(8); PG8_WAIT_L(0); PG8_BAR; PG8_MMA(0, 0, At, B0); PG8_MMA(0, 1, At, B1); PG8_BAR; PG8_SCHED;
            PG8_LDA(At, 0, 1); PG8_STAGE(PG8_SB(0, 0), b2, voffB); PG8_STAGE(PG8_SB(0, 1), b2 + hstep, voffB); PG8_STAGE(PG8_SA(0, 0), a2, voffA);
            PG8_WAIT_V(8); PG8_WAIT_L(0); PG8_BAR; PG8_MMA(1, 0, At, B0); PG8_MMA(1, 1, At, B1); PG8_BAR; PG8_SCHED;
            PG8_LDB(B0, 1, 0); PG8_LDB(B1, 1, 1); PG8_SCHED; PG8_LDA(At, 1, 0); PG8_STAGE(PG8_SA(0, 1), a2 + hstep, voffA);
            PG8_WAIT_V(8); PG8_WAIT_L(0); PG8_BAR; PG8_MMA(0, 0, At, B0); PG8_MMA(0, 1, At, B1); PG8_BAR; PG8_SCHED;
            PG8_LDA(At, 1, 1); PG8_STAGE(PG8_SB(1, 0), b3, voffB); PG8_STAGE(PG8_SB(1, 1), b3 + hstep, voffB); PG8_STAGE(PG8_SA(1, 0), a3, voffA);
            PG8_WAIT_V(8); PG8_WAIT_L(0); PG8_BAR; PG8_MMA(1, 0, At, B0); PG8_MMA(1, 1, At, B1); PG8_BAR; PG8_SCHED;
            } else {
            PG8_LDB(B0, 0, 0); PG8_SCHED; PG8_LDA(At, 0, 0); PG8_STAGE(PG8_SA(1, 1), a1 + hstep, voffA);
            PG8_WAIT_L(8); PG8_BAR; PG8_WAIT_L(0); PG8_MMA(0, 0, At, B0); PG8_BAR; PG8_SCHED;
            PG8_LDB(B1, 0, 1); PG8_STAGE(PG8_SB(0, 0), b2, voffB);
            PG8_BAR; PG8_WAIT_L(0); PG8_MMA(0, 1, At, B1); PG8_BAR;
            PG8_LDA(At, 0, 1); PG8_STAGE(PG8_SA(0, 0), a2, voffA);
            PG8_BAR; PG8_WAIT_L(0); PG8_MMA(1, 0, At, B0); PG8_BAR; PG8_SCHED;
            PG8_STAGE(PG8_SB(0, 1), b2 + hstep, voffB);
            PG8_WAIT_V(6); PG8_BAR; PG8_MMA(1, 1, At, B1); PG8_BAR;
            PG8_LDB(B0, 1, 0); PG8_SCHED; PG8_LDA(At, 1, 0); PG8_STAGE(PG8_SA(0, 1), a2 + hstep, voffA);
            PG8_WAIT_L(8); PG8_BAR; PG8_WAIT_L(0); PG8_MMA(0, 0, At, B0); PG8_BAR; PG8_SCHED;
            PG8_LDB(B1, 1, 1); PG8_STAGE(PG8_SB(1, 0), b3, voffB);
            PG8_BAR; PG8_WAIT_L(0); PG8_MMA(0, 1, At, B1); PG8_BAR;
            PG8_LDA(At, 1, 1); PG8_STAGE(PG8_SA(1, 0), a3, voffA);
            PG8_BAR; PG8_WAIT_L(0); PG8_MMA(1, 0, At, B0); PG8_BAR; PG8_SCHED;
            PG8_STAGE(PG8_SB(1, 1), b3 + hstep, voffB);
            PG8_WAIT_V(6); PG8_BAR; PG8_MMA(1, 1, At, B1); PG8_BAR;
            }
        }
        if constexpr (ALIGN_EPI) { if (wr == 0) PG8_BAR; }
        if constexpr (!Epi::AFTER_DRAIN) { E(acc, cur, wr, wc, fr, fq); S.done(cur); }
        if (!has_next) break;
#pragma unroll
        for (int a = 0; a < 2; ++a)
#pragma unroll
            for (int b = 0; b < 2; ++b)
#pragma unroll
                for (int m = 0; m < 4; ++m)
#pragma unroll
                    for (int n = 0; n < 2; ++n) acc[a][b][m][n] = (f32x4){0.f, 0.f, 0.f, 0.f};
        cur = nxt; cA = nA; cB = nB; ++ui;
        if constexpr (ALIGN_EPI) { if (wr == 1) PG8_BAR; }
    }
    PG8_WAIT_V(0);
    if constexpr (!ALIGN_EPI) { if (wr == 0) PG8_BAR; }
    PG8_BAR;
    if constexpr (Epi::AFTER_DRAIN) { E.fused(acc, cur, wr, wc, fr, fq, lds, wid, lane); S.done(cur); }
#undef PG8_SA
#undef PG8_SB
#undef PG8_STAGE
#undef PG8_LDA
#undef PG8_LDB
#undef PG8_MMA
#undef PG8_WAIT_V
#undef PG8_WAIT_L
#undef PG8_BAR
#undef PG8_SCHED
}
}
#define LAS __attribute__((address_space(3)))
#define DI __device__ __forceinline__
typedef unsigned short bf16_t;
typedef short bf16x8 __attribute__((ext_vector_type(8)));
typedef short s16x4 __attribute__((ext_vector_type(4)));
typedef float f32x4 __attribute__((ext_vector_type(4)));
typedef float f32x16 __attribute__((ext_vector_type(16)));
typedef unsigned u32x4 __attribute__((ext_vector_type(4)));
typedef unsigned u32x2 __attribute__((ext_vector_type(2)));
typedef float f32x2 __attribute__((ext_vector_type(2)));
using pg8::cvt_pk_bf16;
using pg8::silu_f;

constexpr int NTHREADS = 512, NWAVES = 8;
constexpr int DM = 1024, T_LAT = 65536, T_CTX = 8192, T_ALL = T_LAT + T_CTX, SEQ = 2048, CTXL = 256, NB = 32;
constexpr int ATT_W = 2304, GDN_W = 4352, GDN_WREAL = 4128, FFH = 2816;
constexpr float RMS_EPS = 1e-6f;
constexpr int LDS_BYTES = 163840;
constexpr size_t MiB = 1u << 20;
constexpr size_t WS_BAR = 3670016;
constexpr size_t WS_MOD = 0, WS_WIN = 4 * MiB, WS_WOUT = 13 * MiB, WS_WGU = 15 * MiB, WS_WDN = 26 * MiB, WS_XCTX = 32 * MiB, WS_H = 64 * MiB, WS_Y = 208 * MiB, WS_BIG = 352 * MiB, WS_END = 964 * MiB;

struct Args { const float* in[20]; float* out; unsigned char* ws; int ph_lo, ph_hi; };
enum { I_X = 0, I_C, I_CTX, I_CCTX, I_ADAW, I_ADAB, I_NORMG, I_AWIN, I_AWOUT, I_DLAM, I_SUBLN, I_QKG, I_GWIN, I_GCONV, I_GALOG, I_GDT, I_GNORM, I_GWOUT, I_FGU, I_FDN };

DI float bf2f(bf16_t b) { return __uint_as_float((unsigned)b << 16); }
DI float bflo(unsigned u) { return __uint_as_float(u << 16); }
DI float bfhi(unsigned u) { return __uint_as_float(u & 0xffff0000u); }
DI bf16_t f2bf(float f) { return (bf16_t)(cvt_pk_bf16(f, 0.f) & 0xffffu); }
template <int OFF> DI float shx(float v) { return __int_as_float(__builtin_amdgcn_ds_swizzle(__float_as_int(v), (OFF << 10) | 0x1f)); }
DI float swp_other(float v, int h) { auto rr = __builtin_amdgcn_permlane32_swap(__float_as_uint(v), __float_as_uint(v), false, false); return __uint_as_float(h ? rr[0] : rr[1]); }
DI float swp_sum(float v) { auto rr = __builtin_amdgcn_permlane32_swap(__float_as_uint(v), __float_as_uint(v), false, false); return __uint_as_float(rr[0]) + __uint_as_float(rr[1]); }
DI float swp_max(float v) { auto rr = __builtin_amdgcn_permlane32_swap(__float_as_uint(v), __float_as_uint(v), false, false); return fmaxf(__uint_as_float(rr[0]), __uint_as_float(rr[1])); }
DI float wave_sum(float v) { v += shx<1>(v); v += shx<2>(v); v += shx<4>(v); v += shx<8>(v); v += shx<16>(v); return swp_sum(v); }
#define MFMA32(a, b, c) __builtin_amdgcn_mfma_f32_32x32x16_bf16((a), (b), (c), 0, 0, 0)
DI int crow(int r, int h) { return (r & 3) + 8 * (r >> 2) + 4 * h; }
template <int S> DI bf16x8 pack_step(const f32x16& x) {
    u32x4 p; p.x = cvt_pk_bf16(x[8 * S], x[8 * S + 1]); p.y = cvt_pk_bf16(x[8 * S + 2], x[8 * S + 3]); p.z = cvt_pk_bf16(x[8 * S + 4], x[8 * S + 5]); p.w = cvt_pk_bf16(x[8 * S + 6], x[8 * S + 7]);
    return __builtin_bit_cast(bf16x8, p);
}
typedef short v4i16_t __attribute__((ext_vector_type(4)));
DI s16x4 tr_read(LAS const unsigned char* p) { return __builtin_bit_cast(s16x4, __builtin_amdgcn_ds_read_tr16_b64_v4i16((LAS v4i16_t*)p)); }
DI bf16x8 cat8(s16x4 lo, s16x4 hi) { return __builtin_shufflevector(lo, hi, 0, 1, 2, 3, 4, 5, 6, 7); }

struct Ctx {
    const float* const __attribute__((address_space(4)))* in; float* out; unsigned char* ws;
    LAS unsigned char* lds; int wave, G, gw, ngw;
};
DI int get_lane() { int l; asm volatile("v_mbcnt_lo_u32_b32 %0, -1, 0\n\tv_mbcnt_hi_u32_b32 %0, -1, %0" : "=v"(l)); return l; }
#define PHASE_IDS const int LANE = get_lane(); const int TID = F.wave * 64 + LANE; (void)TID;

DI float* xrow(const Ctx& F, int m) { return m < T_LAT ? F.out + (size_t)m * DM : (float*)(F.ws + WS_XCTX) + (size_t)(m - T_LAT) * DM; }
DI const float* xin(const Ctx& F, int m) { return m < T_LAT ? F.in[I_X] + (size_t)m * DM : F.in[I_CTX] + (size_t)(m - T_LAT) * DM; }

DI void transpose_item(const float* W, int K, int N, bf16_t* WT, int k0, int n0, int drow0, LAS float* scr, int lane) {
#pragma unroll 8
    for (int i = 0; i < 32; ++i) { const int kk = 2 * i + (lane >> 5); scr[kk * 33 + (lane & 31)] = __builtin_nontemporal_load(W + (size_t)(k0 + kk) * N + n0 + (lane & 31)); }
    asm volatile("s_waitcnt lgkmcnt(0)" ::: "memory");
    const int c = lane & 7;
#pragma unroll
    for (int j = 0; j < 4; ++j) { const int n = (lane >> 3) + 8 * j; const LAS float* s = scr + (8 * c) * 33 + n;
        u32x4 o; o.x = cvt_pk_bf16(s[0 * 33], s[1 * 33]); o.y = cvt_pk_bf16(s[2 * 33], s[3 * 33]); o.z = cvt_pk_bf16(s[4 * 33], s[5 * 33]); o.w = cvt_pk_bf16(s[6 * 33], s[7 * 33]);
        *(u32x4*)(WT + (size_t)(drow0 + n) * K + k0 + 8 * c) = o; }
    asm volatile("s_waitcnt lgkmcnt(0)" ::: "memory");
}
DI void wconv_layer(const Ctx& F, int l) {
    PHASE_IDS
    LAS float* scr = (LAS float*)(F.lds + F.wave * 8448);
    const int i2 = l >> 1; const bool odd = l & 1;
    const float* Win = odd ? F.in[I_GWIN] + (size_t)i2 * DM * GDN_WREAL : F.in[I_AWIN] + (size_t)i2 * DM * ATT_W;
    const float* Wout = odd ? F.in[I_GWOUT] + (size_t)i2 * DM * DM : F.in[I_AWOUT] + (size_t)i2 * DM * DM;
    const float* Wgu = F.in[I_FGU] + (size_t)l * DM * 2 * FFH; const float* Wdn = F.in[I_FDN] + (size_t)l * FFH * DM;
    bf16_t* win_t = (bf16_t*)(F.ws + WS_WIN); bf16_t* wout_t = (bf16_t*)(F.ws + WS_WOUT); bf16_t* wgu_t = (bf16_t*)(F.ws + WS_WGU); bf16_t* wdn_t = (bf16_t*)(F.ws + WS_WDN);
    const int Nin = odd ? GDN_WREAL : ATT_W;
    const int n_in = 16 * (Nin / 32), n_out = 16 * 32, n_gu = 16 * (2 * FFH / 32), n_dn = (FFH / 64) * 32, n_zero = odd ? (GDN_W - GDN_WREAL) : 0;
    const int total = n_in + n_out + n_gu + n_dn + n_zero;
    for (int it = F.gw; it < total; it += F.ngw) {
        int r = it;
        if (r < n_in) { const int nb = Nin / 32, kb = r / nb, nn = r % nb; transpose_item(Win, DM, Nin, win_t, 64 * kb, 32 * nn, 32 * nn, scr, LANE); continue; } r -= n_in;
        if (r < n_out) { const int kb = r / 32, nn = r % 32; transpose_item(Wout, DM, DM, wout_t, 64 * kb, 32 * nn, 32 * nn, scr, LANE); continue; } r -= n_out;
        if (r < n_gu) { const int nb = 2 * FFH / 32, kb = r / nb, nn = r % nb; const int n0 = 32 * nn, half = n0 / FFH, jj = n0 % FFH; const int drow = (jj / 128) * 256 + half * 128 + (jj % 128);
            transpose_item(Wgu, DM, 2 * FFH, wgu_t, 64 * kb, n0, drow, scr, LANE); continue; } r -= n_gu;
        if (r < n_dn) { const int kb = r / 32, nn = r % 32; transpose_item(Wdn, FFH, DM, wdn_t, 64 * kb, 32 * nn, 32 * nn, scr, LANE); continue; } r -= n_dn;
        { u32x4 z = {0u, 0u, 0u, 0u}; u32x4* p = (u32x4*)(win_t + (size_t)(GDN_WREAL + r) * DM); p[LANE] = z; p[LANE + 64] = z; }
    }
}

DI void modvec_phase(const Ctx& F) {
    PHASE_IDS
    LAS float* sc = (LAS float*)F.lds;
    float* MOD = (float*)(F.ws + WS_MOD);
    for (int it = blockIdx.x; it < 4 * 96; it += F.G) {
        for (int idx = TID; idx < 33 * 1024; idx += NTHREADS) { const int bb = idx >> 10, k = idx & 1023; const float v = bb < 32 ? F.in[I_C][bb * 1024 + k] : F.in[I_CCTX][k]; sc[idx] = silu_f(v); }
        __syncthreads();
        const int l = it / 96, col = (it % 96) * 64 + LANE, k0 = F.wave * 128;
        const float* w = F.in[I_ADAW] + (size_t)l * DM * 6144 + col;
        float acc[33];
#pragma unroll
        for (int i = 0; i < 33; ++i) acc[i] = 0.f;
        for (int k = k0; k < k0 + 128; k += 16) {
            float wv[16];
#pragma unroll
            for (int j = 0; j < 16; ++j) wv[j] = __builtin_nontemporal_load(w + (size_t)(k + j) * 6144);
            int zd = 0;
#pragma unroll
            for (int j4 = 0; j4 < 4; ++j4) {
                const LAS unsigned char* scb = (const LAS unsigned char*)(sc + k + 4 * j4) + zd;
#pragma unroll
                for (int i = 0; i < 33; ++i) { const f32x4 s = *(const LAS f32x4*)(scb + i * 4096); acc[i] += (s[0] * wv[4 * j4] + s[1] * wv[4 * j4 + 1]) + (s[2] * wv[4 * j4 + 2] + s[3] * wv[4 * j4 + 3]); }
                asm volatile("v_and_b32 %0, 0, %1" : "=v"(zd) : "v"(acc[0]), "v"(acc[8]), "v"(acc[16]), "v"(acc[24]), "v"(acc[32]));
            }
        }
        __syncthreads();
#pragma unroll
        for (int i = 0; i < 33; ++i) sc[(F.wave * 33 + i) * 64 + LANE] = acc[i];
        __syncthreads();
        const float* bs = F.in[I_ADAB] + l * 6144 + (it % 96) * 64;
        for (int o = TID; o < 33 * 64; o += NTHREADS) { const int bb = o >> 6, c = o & 63; float sum = bs[c];
#pragma unroll
            for (int wv_ = 0; wv_ < 8; ++wv_) sum += sc[(wv_ * 33 + bb) * 64 + c];
            MOD[(size_t)(l * 33 + bb) * 6144 + (it % 96) * 64 + c] = sum; }
        __syncthreads();
    }
}

DI void rowwise_phase(const Ctx& F, int stage, int l, int Mrows) {
    PHASE_IDS
    const float* MOD = (const float*)(F.ws + WS_MOD); const float* NG = F.in[I_NORMG];
    bf16_t* H = (bf16_t*)(F.ws + WS_H); const bf16_t* Y = (const bf16_t*)(F.ws + WS_Y);
    const bool needh = !(stage == 2 && l == 3), xfromin = (stage == 0) || (stage == 1 && l == 0);
    const int lh = (stage == 2) ? l + 1 : l;
    const int rpw = (Mrows + F.ngw - 1) / F.ngw, mb = F.gw * rpw, me = (mb + rpw < Mrows) ? mb + rpw : Mrows;
    if (mb >= me) return;
    f32x4 ga[4], gb[4], gt[4], sh[4], sc[4];
#pragma unroll
    for (int j = 0; j < 4; ++j) { ga[j] = (f32x4){0.f, 0.f, 0.f, 0.f}; gb[j] = ga[j]; gt[j] = ga[j]; sh[j] = ga[j]; sc[j] = ga[j]; }
    if (stage != 0) { const float* gap = NG + (size_t)(l * 4 + (stage == 1 ? 1 : 3)) * DM;
#pragma unroll
        for (int j = 0; j < 4; ++j) ga[j] = ((const f32x4*)gap)[LANE + 64 * j]; }
    if (needh) { const float* gbp = NG + (size_t)(lh * 4 + (stage == 1 ? 2 : 0)) * DM;
#pragma unroll
        for (int j = 0; j < 4; ++j) gb[j] = ((const f32x4*)gbp)[LANE + 64 * j]; }
    int cur_bb = -1;
    bf16_t* XL = (bf16_t*)((unsigned char*)F.out + 128 * MiB); float* XF = (float*)(F.ws + WS_BIG + 352 * MiB); float* XC = (float*)(F.ws + WS_XCTX);
    f32x4 xn[4]; u32x2 yn[4], xbn[4];
#define RW_SRC16(m_) (!xfromin && (m_) < T_LAT && !(l == 3 && stage == 2))
#define RW_FETCH(m_) do { if (RW_SRC16(m_)) { const u32x2* xb_ = (const u32x2*)(XL + (size_t)(m_) * DM) + LANE; _Pragma("unroll") for (int j = 0; j < 4; ++j) xbn[j] = __builtin_nontemporal_load(xb_ + 64 * j); } \
        else { const float* xr_ = xfromin ? xin(F, (m_)) : ((m_) >= T_LAT ? XC + (size_t)((m_) - T_LAT) * DM : XF + (size_t)(m_) * DM); const f32x4* xp_ = (const f32x4*)xr_ + LANE; \
            _Pragma("unroll") for (int j = 0; j < 4; ++j) xn[j] = __builtin_nontemporal_load(xp_ + 64 * j); } \
        if (stage != 0) { const u32x2* yp_ = (const u32x2*)(Y + (size_t)(m_) * DM) + LANE; _Pragma("unroll") for (int j = 0; j < 4; ++j) yn[j] = __builtin_nontemporal_load(yp_ + 64 * j); } } while (0)
#pragma unroll
    for (int j = 0; j < 4; ++j) { yn[j] = (u32x2){0u, 0u}; xbn[j] = (u32x2){0u, 0u}; xn[j] = (f32x4){0.f, 0.f, 0.f, 0.f}; }
    RW_FETCH(mb);
    for (int m = mb; m < me; ++m) {
        f32x4 x[4]; u32x2 yw[4];
#pragma unroll
        for (int j = 0; j < 4; ++j) { x[j] = RW_SRC16(m) ? (f32x4){bflo(xbn[j].x), bfhi(xbn[j].x), bflo(xbn[j].y), bfhi(xbn[j].y)} : xn[j]; yw[j] = yn[j]; }
        if (m + 1 < me) RW_FETCH(m + 1);
        const int bb = m < T_LAT ? (m >> 11) : 32;
        if (bb != cur_bb) { cur_bb = bb;
            if (stage != 0) { const float* md = MOD + (size_t)(l * 33 + bb) * 6144 + (stage == 1 ? 2 * 1024 : 5 * 1024);
#pragma unroll
                for (int j = 0; j < 4; ++j) gt[j] = ((const f32x4*)md)[LANE + 64 * j]; }
            if (needh) { const float* md = MOD + (size_t)(lh * 33 + bb) * 6144 + (stage == 1 ? 3 * 1024 : 0);
#pragma unroll
                for (int j = 0; j < 4; ++j) { sh[j] = ((const f32x4*)md)[LANE + 64 * j]; sc[j] = ((const f32x4*)(md + 1024))[LANE + 64 * j]; } }
        }
        if (stage != 0) {
            f32x4 y[4]; float ss = 0.f;
#pragma unroll
            for (int j = 0; j < 4; ++j) { y[j] = (f32x4){bflo(yw[j].x), bfhi(yw[j].x), bflo(yw[j].y), bfhi(yw[j].y)}; ss += (y[j][0] * y[j][0] + y[j][1] * y[j][1]) + (y[j][2] * y[j][2] + y[j][3] * y[j][3]); }
            const float ry = rsqrtf(wave_sum(ss) * (1.f / DM) + RMS_EPS);
#pragma unroll
            for (int j = 0; j < 4; ++j) x[j] = x[j] + gt[j] * (y[j] * ry * ga[j]);
            if (m < T_LAT && l != 3) { u32x2* xo = (u32x2*)(XL + (size_t)m * DM) + LANE;
#pragma unroll
                for (int j = 0; j < 4; ++j) { u32x2 w; w.x = cvt_pk_bf16(x[j][0], x[j][1]); w.y = cvt_pk_bf16(x[j][2], x[j][3]); __builtin_nontemporal_store(w, xo + 64 * j); } }
            else { float* xr = (m >= T_LAT) ? XC + (size_t)(m - T_LAT) * DM : (stage == 1 ? XF + (size_t)m * DM : F.out + (size_t)m * DM); f32x4* xo = (f32x4*)xr + LANE;
#pragma unroll
                for (int j = 0; j < 4; ++j) xo[64 * j] = x[j]; }
        }
        if (!needh) continue;
        float s2 = 0.f;
#pragma unroll
        for (int j = 0; j < 4; ++j) s2 += (x[j][0] * x[j][0] + x[j][1] * x[j][1]) + (x[j][2] * x[j][2] + x[j][3] * x[j][3]);
        const float rx = rsqrtf(wave_sum(s2) * (1.f / DM) + RMS_EPS);
        u32x2* hp = (u32x2*)(H + (size_t)m * DM) + LANE;
#pragma unroll
        for (int j = 0; j < 4; ++j) { const f32x4 hv = (x[j] * rx * gb[j]) * (sc[j] + 1.0f) + sh[j]; u32x2 w; w.x = cvt_pk_bf16(hv[0], hv[1]); w.y = cvt_pk_bf16(hv[2], hv[3]); hp[64 * j] = w; }
    }
#undef RW_FETCH
#undef RW_SRC16
}
constexpr float QSCALE = 0.125f * 1.4426950408889634f;
DI void attn_prep_phase(const Ctx& F, int i2) {
    PHASE_IDS
    bf16_t* P = (bf16_t*)(F.ws + WS_BIG);
    const int sub = LANE & 15, hsel = LANE >> 4;
    const f32x4 qg0 = *(const f32x4*)(F.in[I_QKG] + (i2 * 2 + 0) * 64 + 4 * sub), qg1 = *(const f32x4*)(F.in[I_QKG] + (i2 * 2 + 1) * 64 + 4 * sub);
    float inv_freq[4];
#pragma unroll
    for (int e = 0; e < 4; ++e) inv_freq[e] = exp2f(-(float)(2 * (4 * (sub & 3) + e)) * (1.0f / 32.0f) * 13.287712379549449f);
    const float sgn = (sub & 4) ? 1.0f : -1.0f;
    const int rpw = (T_ALL + F.ngw - 1) / F.ngw, mb = F.gw * rpw, me = (mb + rpw < T_ALL) ? mb + rpw : T_ALL;
    u32x2 wn[7];
#define AP_FETCH(m_) do { const bf16_t* row_ = P + (size_t)(m_) * ATT_W + hsel * 64 + 4 * sub; \
        _Pragma("unroll") for (int g = 0; g < 7; ++g) { const int c0 = (g < 4) ? 256 * g : 1536 + 256 * (g - 4); wn[g] = (u32x2){0u, 0u}; if (g == 6 && hsel < 2) wn[g] = __builtin_nontemporal_load((const u32x2*)(row_ + c0)); } } while (0)
    if (mb < me) AP_FETCH(mb);
    for (int m = mb; m < me; ++m) {
        bf16_t* row = P + (size_t)m * ATT_W + hsel * 64 + 4 * sub;
        float cs[4] = {1.f, 1.f, 1.f, 1.f}, sn[4] = {0.f, 0.f, 0.f, 0.f};
        if (m < T_LAT) { const int t = m & (SEQ - 1); const float pos = (float)((sub < 8) ? (t >> 6) : (t & 63));
#pragma unroll
            for (int e = 0; e < 4; ++e) sincosf(pos * inv_freq[e], &sn[e], &cs[e]); }
        u32x2 w[7];
#pragma unroll
        for (int g = 0; g < 7; ++g) w[g] = wn[g];
        if (m + 1 < me) AP_FETCH(m + 1);
#pragma unroll
        for (int g = 0; g < 7; ++g) {
            if (g != 6) continue;
            float v[4] = {bflo(w[g].x), bfhi(w[g].x), bflo(w[g].y), bfhi(w[g].y)};
            if (g >= 4) { float ss = (v[0] * v[0] + v[1] * v[1]) + (v[2] * v[2] + v[3] * v[3]); ss += shx<1>(ss); ss += shx<2>(ss); ss += shx<4>(ss); ss += shx<8>(ss);
                const float rs = rsqrtf(ss * (1.0f / 64.0f) + RMS_EPS); const f32x4 gg = (g < 6) ? qg0 : qg1;
#pragma unroll
                for (int e = 0; e < 4; ++e) v[e] = v[e] * rs * gg[e]; }
            const float scl = (g < 2 || g == 4 || g == 5) ? QSCALE : 1.0f;
            float o[4];
#pragma unroll
            for (int e = 0; e < 4; ++e) { const float pr = shx<4>(v[e]); o[e] = (v[e] * cs[e] + sgn * pr * sn[e]) * scl; }
            const int c0 = (g < 4) ? 256 * g : 1536 + 256 * (g - 4);
            u32x2 ow; ow.x = cvt_pk_bf16(o[0], o[1]); ow.y = cvt_pk_bf16(o[2], o[3]);
            if (g < 6 || hsel < 2) *(u32x2*)(row + c0) = ow;
        }
    }
}

constexpr int AK_PITCH = 144, AK_BYTES = 64 * AK_PITCH;
template <int DVT> struct AttnGeo { static constexpr int VP = (DVT == 4) ? 320 : 192, VBYTES = 64 * VP, VOFF = 4 * AK_BYTES; };
template <int DVT>
DI void attn_pass(f32x16 (&acc)[DVT], float& lsum, const Ctx& F, const bf16_t* P, int b, bool ctxq, int qrow, int qcol, int kcol, int vcol, const float* qgam) {
    PHASE_IDS
    typedef AttnGeo<DVT> GEO;
    const int lane = LANE, tid = TID, l31 = lane & 31, h = lane >> 5;
    LAS unsigned char* lds = F.lds;
    const int nt = ctxq ? 4 : 36;
    bf16x8 qf[4];
    {
        float q[4][8];
#pragma unroll
        for (int ks = 0; ks < 4; ++ks) { const u32x4 w = __builtin_nontemporal_load((const u32x4*)(P + (size_t)qrow * ATT_W + qcol + ks * 16 + h * 8));
            q[ks][0] = bflo(w.x); q[ks][1] = bfhi(w.x); q[ks][2] = bflo(w.y); q[ks][3] = bfhi(w.y); q[ks][4] = bflo(w.z); q[ks][5] = bfhi(w.z); q[ks][6] = bflo(w.w); q[ks][7] = bfhi(w.w); }
        if (qgam) {
            float ss = 0.f;
#pragma unroll
            for (int ks = 0; ks < 4; ++ks)
#pragma unroll
                for (int j = 0; j < 8; ++j) ss += q[ks][j] * q[ks][j];
            ss = swp_sum(ss);
            const float rs = rsqrtf(ss * (1.0f / 64.0f) + RMS_EPS);
#pragma unroll
            for (int ks = 0; ks < 4; ++ks) { const f32x4 g0 = *(const f32x4*)(qgam + ks * 16 + h * 8), g1 = *(const f32x4*)(qgam + ks * 16 + h * 8 + 4);
#pragma unroll
                for (int j = 0; j < 4; ++j) { q[ks][j] *= rs * g0[j]; q[ks][4 + j] *= rs * g1[j]; } }
        }
        if (!ctxq) {
            const int tq = qrow & (SEQ - 1); const float pr = (float)(tq >> 6), pc = (float)(tq & 63);
#pragma unroll
            for (int j = 0; j < 8; ++j) {
                const float fr = exp2f(-(float)(2 * (8 * h + j)) * (1.0f / 32.0f) * 13.287712379549449f);
                const float sr = __sinf(pr * fr), cr = __cosf(pr * fr), sc_ = __sinf(pc * fr), cc = __cosf(pc * fr);
                const float a0 = q[0][j], a1 = q[1][j], b0 = q[2][j], b1 = q[3][j];
                q[0][j] = a0 * cr - a1 * sr; q[1][j] = a1 * cr + a0 * sr; q[2][j] = b0 * cc - b1 * sc_; q[3][j] = b1 * cc + b0 * sc_;
            }
        }
#pragma unroll
        for (int ks = 0; ks < 4; ++ks) { u32x4 w; w.x = cvt_pk_bf16(q[ks][0] * QSCALE, q[ks][1] * QSCALE); w.y = cvt_pk_bf16(q[ks][2] * QSCALE, q[ks][3] * QSCALE); w.z = cvt_pk_bf16(q[ks][4] * QSCALE, q[ks][5] * QSCALE); w.w = cvt_pk_bf16(q[ks][6] * QSCALE, q[ks][7] * QSCALE);
            qf[ks] = __builtin_bit_cast(bf16x8, w); }
    }
#pragma unroll
    for (int t = 0; t < DVT; ++t)
#pragma unroll
        for (int r = 0; r < 16; ++r) acc[t][r] = 0.f;
    float mrun = 0.f; lsum = 0.f;
    float nref = 0.f;
    const int krow_s = tid >> 3, kch = tid & 7;
    u32x4 kregA, vregA[DVT / 2];
#define A_ROWBASE(t) ((t) < 4 ? (T_LAT + b * CTXL + 64 * (t)) : (b * SEQ + 64 * ((t) - 4)))
#define A_GLOAD(t, kreg, vreg) do { const int rb_ = A_ROWBASE(t); kreg = *(const u32x4*)(P + (size_t)(rb_ + krow_s) * ATT_W + kcol + kch * 8); \
        if (DVT == 4) { _Pragma("unroll") for (int i_ = 0; i_ < DVT / 2; ++i_) { const int idx_ = tid + 512 * i_; vreg[i_] = *(const u32x4*)(P + (size_t)(rb_ + (idx_ >> 4)) * ATT_W + vcol + (idx_ & 15) * 8); } } \
        else { vreg[0] = *(const u32x4*)(P + (size_t)(rb_ + krow_s) * ATT_W + vcol + kch * 8); } } while (0)
#define A_LSTORE(buf, kreg, vreg) do { *(LAS u32x4*)(lds + (buf) * AK_BYTES + krow_s * AK_PITCH + kch * 16) = kreg;   \
        if (DVT == 4) { _Pragma("unroll") for (int i_ = 0; i_ < DVT / 2; ++i_) { const int idx_ = tid + 512 * i_; *(LAS u32x4*)(lds + GEO::VOFF + (buf) * GEO::VBYTES + (idx_ >> 4) * GEO::VP + (idx_ & 15) * 16) = vreg[i_]; } } \
        else { *(LAS u32x4*)(lds + GEO::VOFF + (buf) * GEO::VBYTES + krow_s * GEO::VP + kch * 16) = vreg[0]; } } while (0)
    const int q4 = (lane & 15) >> 2, p4 = lane & 3, blk = (lane >> 4) & 1;
#define A_TILE(t, cur) do { \
        f32x16 s0, s1; _Pragma("unroll") for (int r = 0; r < 16; ++r) { s0[r] = nref; s1[r] = nref; } \
        const LAS unsigned char* kb = lds + (cur) * AK_BYTES + l31 * AK_PITCH + h * 16; \
        _Pragma("unroll") for (int ks = 0; ks < 4; ++ks) { \
            const bf16x8 a0 = *(const LAS bf16x8*)(kb + ks * 32), a1 = *(const LAS bf16x8*)(kb + 32 * AK_PITCH + ks * 32); \
            s0 = MFMA32(a0, qf[ks], s0); s1 = MFMA32(a1, qf[ks], s1); } \
        float mx = fmaxf(fmaxf(s0[0], s0[1]), s1[0]); \
        _Pragma("unroll") for (int r = 2; r < 16; r += 2) mx = fmaxf(fmaxf(mx, s0[r]), s0[r + 1]); \
        _Pragma("unroll") for (int r = 1; r < 15; r += 2) mx = fmaxf(fmaxf(mx, s1[r]), s1[r + 1]); \
        mx = fmaxf(mx, s1[15]); \
        mx = swp_max(mx); \
        if ((t) == 0 || __builtin_amdgcn_ballot_w64(mx > 6.0f) != 0ull) { \
            const float dl = ((t) == 0) ? mx : fmaxf(mx, 0.f), alpha = ((t) == 0) ? 1.0f : __builtin_amdgcn_exp2f(-dl); \
            mrun += dl; lsum *= alpha; \
            _Pragma("unroll") for (int r = 0; r < 16; ++r) { s0[r] -= dl; s1[r] -= dl; } nref = -mrun; \
            _Pragma("unroll") for (int tt = 0; tt < DVT; ++tt) _Pragma("unroll") for (int r = 0; r < 16; ++r) acc[tt][r] *= alpha; } \
        float psum = 0.f; \
        _Pragma("unroll") for (int r = 0; r < 16; ++r) { s0[r] = __builtin_amdgcn_exp2f(s0[r]); s1[r] = __builtin_amdgcn_exp2f(s1[r]); psum += s0[r] + s1[r]; } \
        lsum += psum; \
        bf16x8 pf[4]; pf[0] = pack_step<0>(s0); pf[1] = pack_step<1>(s0); pf[2] = pack_step<0>(s1); pf[3] = pack_step<1>(s1); \
        const LAS unsigned char* vb = lds + GEO::VOFF + (cur) * GEO::VBYTES + (4 * h + q4) * GEO::VP + (16 * blk + 4 * p4) * 2; \
        _Pragma("unroll") for (int kk = 0; kk < 4; ++kk) { const int kbase = 32 * (kk >> 1) + 16 * (kk & 1); \
            _Pragma("unroll") for (int tt = 0; tt < DVT; ++tt) { \
                const s16x4 lo = tr_read(vb + kbase * GEO::VP + tt * 64), hi = tr_read(vb + (kbase + 8) * GEO::VP + tt * 64); \
                acc[tt] = MFMA32(cat8(lo, hi), pf[kk], acc[tt]); } } } while (0)
    A_GLOAD(0, kregA, vregA); A_LSTORE(0, kregA, vregA); A_GLOAD(1, kregA, vregA); A_LSTORE(1, kregA, vregA);
    __syncthreads();
    const int ns = nt >> 1;
    for (int sg = 0; sg < ns; ++sg) {
        const int sb = (sg & 1) * 2;
        if (sg + 1 < ns) A_GLOAD(2 * sg + 2, kregA, vregA);
        A_TILE(2 * sg, sb);
        if (sg + 1 < ns) { A_LSTORE((sb ^ 2), kregA, vregA); A_GLOAD(2 * sg + 3, kregA, vregA); }
        A_TILE(2 * sg + 1, sb + 1);
        if (sg + 1 < ns) A_LSTORE((sb ^ 2) + 1, kregA, vregA);
        __syncthreads();
    }
#undef A_TILE
    lsum = swp_sum(lsum);
#undef A_ROWBASE
#undef A_GLOAD
#undef A_LSTORE
}

DI void attn_phase(const Ctx& F, int l) {
    PHASE_IDS
    const int i2 = l >> 1; const bf16_t* P = (const bf16_t*)(F.ws + WS_BIG); bf16_t* O = (bf16_t*)(F.ws + WS_H);
    const int lane = LANE, l31 = lane & 31, h = lane >> 5;
    const float lam_init = 0.8f - 0.6f * expf(-0.3f * (float)l);
    float lam;
    { const float* lv = F.in[I_DLAM] + i2 * 256; const float a = wave_sum(lv[lane] * lv[64 + lane]), bsum = wave_sum(lv[128 + lane] * lv[192 + lane]); lam = expf(a) - expf(bsum) + lam_init; }
    constexpr int NU = 1024 + 2048 + 128 + 256;
    const int vcu = (F.G % 8 == 0) ? ((int)blockIdx.x % 8) * (F.G / 8) + (int)blockIdx.x / 8 : (int)blockIdx.x;
    for (int u = vcu; u < NU; u += F.G) {
        int b, hd, qb; bool diff, ctxq;
        if (u < 1024) { diff = true; ctxq = false; b = u >> 5; hd = (u >> 3) & 3; qb = u & 7; }
        else if (u < 3072) { const int v = u - 1024; diff = false; ctxq = false; b = v >> 6; hd = (v >> 3) & 7; qb = v & 7; }
        else if (u < 3200) { const int v = u - 3072; diff = true; ctxq = true; b = v >> 2; hd = v & 3; qb = 0; }
        else { const int v = u - 3200; diff = false; ctxq = true; b = v >> 3; hd = v & 7; qb = 0; }
        const int qrow = (ctxq ? T_LAT + b * CTXL : b * SEQ + qb * 256) + F.wave * 32 + l31;
        if (diff) {
            f32x16 a1[4], a2[4]; float l1, l2;
            attn_pass<4>(a1, l1, F, P, b, ctxq, qrow, hd * 128, 512 + hd * 128, 1024 + hd * 128, nullptr);
            attn_pass<4>(a2, l2, F, P, b, ctxq, qrow, hd * 128 + 64, 512 + hd * 128 + 64, 1024 + hd * 128, nullptr);
            const float i1 = 1.0f / l1, i2s = lam / l2; float ss = 0.f;
#pragma unroll
            for (int t = 0; t < 4; ++t)
#pragma unroll
                for (int r = 0; r < 16; ++r) { const float o = a1[t][r] * i1 - a2[t][r] * i2s; a1[t][r] = o; ss += o * o; }
            ss = swp_sum(ss);
            const float rs = rsqrtf(ss * (1.0f / 128.0f) + RMS_EPS) * (1.0f - lam_init);
            const float* sg = F.in[I_SUBLN] + i2 * 128;
            bf16_t* orow = O + (size_t)qrow * DM + hd * 128;
#pragma unroll
            for (int t = 0; t < 4; ++t)
#pragma unroll
                for (int g = 0; g < 4; ++g) { const int dv = t * 32 + 8 * g + 4 * h; const f32x4 gg = *(const f32x4*)(sg + dv);
                    u32x2 w; w.x = cvt_pk_bf16(a1[t][4 * g] * rs * gg[0], a1[t][4 * g + 1] * rs * gg[1]); w.y = cvt_pk_bf16(a1[t][4 * g + 2] * rs * gg[2], a1[t][4 * g + 3] * rs * gg[3]);
                    *(u32x2*)(orow + dv) = w; }
        } else {
            f32x16 a1[2]; float l1;
            attn_pass<2>(a1, l1, F, P, b, ctxq, qrow, 1536 + hd * 64, 2048 + (hd >> 2) * 64, 2176 + (hd >> 2) * 64, F.in[I_QKG] + (i2 * 2 + 0) * 64);
            const float i1 = 1.0f / l1;
            bf16_t* orow = O + (size_t)qrow * DM + 512 + hd * 64;
#pragma unroll
            for (int t = 0; t < 2; ++t)
#pragma unroll
                for (int g = 0; g < 4; ++g) { const int dv = t * 32 + 8 * g + 4 * h;
                    u32x2 w; w.x = cvt_pk_bf16(a1[t][4 * g] * i1, a1[t][4 * g + 1] * i1); w.y = cvt_pk_bf16(a1[t][4 * g + 2] * i1, a1[t][4 * g + 3] * i1);
                    *(u32x2*)(orow + dv) = w; }
        }
    }
}
constexpr int GP = 272;
constexpr int GU_Q = 0, GU_K = 64 * GP, GU_V = 2 * 64 * GP, GU_M = 3 * 64 * GP, GU_ATT = 4 * 64 * GP, GU_SC = GU_ATT + 6144, GU_M10 = GU_SC + 1024, GU_BYTES = 80896;
DI f32x16 tile_nt(const LAS unsigned char* A, const LAS unsigned char* B, int l31, int h) {
    f32x16 c;
#pragma unroll
    for (int r = 0; r < 16; ++r) c[r] = 0.f;
    const LAS unsigned char* ap = A + l31 * GP + h * 16; const LAS unsigned char* bp = B + l31 * GP + h * 16;
#pragma unroll
    for (int ks = 0; ks < 8; ++ks) c = MFMA32(*(const LAS bf16x8*)(ap + ks * 32), *(const LAS bf16x8*)(bp + ks * 32), c);
    return c;
}
DI float softplus_f(float x) { const float e = __expf(x); const float sm = e * (1.0f - e * (0.5f - e * 0.33333334f)); return x > 20.f ? x : (e < 0.01f ? sm : __logf(1.0f + e)); }

DI void gdn_scan_phase(const Ctx& F, int l) {
    const int i2 = l >> 1;
    const bf16_t* P = (const bf16_t*)(F.ws + WS_BIG);
    const float* convw = F.in[I_GCONV] + (size_t)i2 * 4 * 3072;
    const int w4 = F.wave & 3, ub = F.wave >> 2;
    const int e0 = 32 * w4;
    for (int u0 = 2 * blockIdx.x; u0 < 512; u0 += 2 * F.G) {
        const int u = u0 + ub, b = u >> 4, hd = (u >> 1) & 7, dir = u & 1;
        bf16_t* Od = (bf16_t*)(F.ws + (dir ? WS_Y : WS_H));
        const float nalog = __uint_as_float(__builtin_amdgcn_readfirstlane(__float_as_uint(-__expf(F.in[I_GALOG][i2 * 16 + dir * 8 + hd])))), dtb = __uint_as_float(__builtin_amdgcn_readfirstlane(__float_as_uint(F.in[I_GDT][i2 * 16 + dir * 8 + hd])));
        f32x16 S[4];
#pragma unroll
        for (int t = 0; t < 4; ++t)
#pragma unroll
            for (int r = 0; r < 16; ++r) S[t][r] = 0.f;
        for (int step = 0; step < 36; ++step) {
            const bool isctx = step < 4; const int cidx = dir ? (isctx ? 3 - step : 35 - step) : (isctx ? step : step - 4);
            const int seq0 = isctx ? T_LAT + b * CTXL : b * SEQ, L = isctx ? CTXL : SEQ, t0 = 64 * cidx;
            const int lane = get_lane(); const int ut = (F.wave & 3) * 64 + lane;
            const int l31 = lane & 31, h = lane >> 5, q4 = (lane & 15) >> 2, p4 = lane & 3, blk = (lane >> 4) & 1;
            int zs; asm volatile("s_mov_b32 %0, 0" : "=s"(zs));
            LAS unsigned char* U = F.lds + ub * GU_BYTES + zs;
            LAS float* SC = (LAS float*)(U + GU_SC);
            const LAS float* SCh = SC + 4 * h + zs;
#ifndef GDN_NOSTAGE
            unsigned pf0 = 0u, pf1 = 0u;
            {
                const int seg = ut >> 4, cg8 = ut & 15;
                const float* cwl = convw + zs;
                const bf16_t* pbase = P + (size_t)seq0 * GDN_W + hd * 128 + cg8 * 8;
                u32x4 rawA[7], rawB[7];
#define GS_LOAD(raw, MAT) do { _Pragma("unroll") for (int rr = 0; rr < 7; ++rr) { const int ts = t0 + 4 * seg - 2 + rr; u32x4 w_ = {0u, 0u, 0u, 0u}; \
                    if (ts >= 0 && ts < L) w_ = *(const u32x4*)(pbase + (size_t)ts * GDN_W + (MAT) * 1024); raw[rr] = w_; } } while (0)
#define GS_PROC(raw, MAT) do { const int col0 = (MAT) * 1024 + hd * 128 + cg8 * 8; float o[4][8]; \
                    _Pragma("unroll") for (int a = 0; a < 4; ++a) _Pragma("unroll") for (int c = 0; c < 8; ++c) o[a][c] = 0.f; \
                    _Pragma("unroll") for (int j = 0; j < 4; ++j) { const f32x4 wa = *(const f32x4*)(cwl + j * 3072 + col0), wb = *(const f32x4*)(cwl + j * 3072 + col0 + 4); \
                        _Pragma("unroll") for (int a = 0; a < 4; ++a) { const u32x4 w_ = raw[a + j]; \
                            o[a][0] += wa[0] * bflo(w_.x); o[a][1] += wa[1] * bfhi(w_.x); o[a][2] += wa[2] * bflo(w_.y); o[a][3] += wa[3] * bfhi(w_.y); \
                            o[a][4] += wb[0] * bflo(w_.z); o[a][5] += wb[1] * bfhi(w_.z); o[a][6] += wb[2] * bflo(w_.w); o[a][7] += wb[3] * bfhi(w_.w); } } \
                    _Pragma("unroll") for (int a = 0; a < 4; ++a) { float ss = 0.f; \
                        _Pragma("unroll") for (int c = 0; c < 8; ++c) { o[a][c] = silu_f(o[a][c]); ss += o[a][c] * o[a][c]; } \
                        float sc = 1.0f; \
                        if ((MAT) < 2) { ss += shx<1>(ss); ss += shx<2>(ss); ss += shx<4>(ss); ss += shx<8>(ss); sc = rsqrtf(ss + 1e-6f) * ((MAT) == 0 ? 0.08838834764831845f : 1.0f); } \
                        const int tk = 4 * seg + a, row = dir ? 63 - tk : tk; \
                        u32x4 w; w.x = cvt_pk_bf16(o[a][0] * sc, o[a][1] * sc); w.y = cvt_pk_bf16(o[a][2] * sc, o[a][3] * sc); w.z = cvt_pk_bf16(o[a][4] * sc, o[a][5] * sc); w.w = cvt_pk_bf16(o[a][6] * sc, o[a][7] * sc); \
                        *(LAS u32x4*)(U + (MAT) * 64 * GP + row * GP + cg8 * 16) = w; } } while (0)
                bf16_t av_r = 0, bv_r = 0;
                if (w4 == 0) { const int tk = dir ? 63 - lane : lane; const bf16_t* prow = P + (size_t)(seq0 + t0 + tk) * GDN_W + 4096 + dir * 8 + hd; av_r = prow[0]; bv_r = prow[16]; }
                GS_LOAD(rawA, 0); GS_LOAD(rawB, 1);
                GS_PROC(rawA, 0);
                GS_LOAD(rawA, 2);
                GS_PROC(rawB, 1);
                GS_PROC(rawA, 2);
#undef GS_LOAD
#undef GS_PROC
                if (w4 == 0) {
                    const float av = bf2f(av_r), bv = bf2f(bv_r);
                    float g = nalog * softplus_f(av + dtb);
#pragma unroll
                    for (int off = 1; off < 64; off <<= 1) { const float t_ = __int_as_float(__builtin_amdgcn_ds_bpermute((lane - off) << 2, __float_as_int(g))); if (lane >= off) g += t_; }
                    const float glast = __int_as_float(__builtin_amdgcn_readlane(__float_as_int(g), 63));
                    SC[lane] = g; SC[64 + lane] = 1.0f / (1.0f + __expf(-bv)); SC[128 + lane] = __expf(g); SC[192 + lane] = __expf(glast - g);
                }
                if (step + 1 < 36) {
                    const int st1 = step + 1; const bool ic1 = st1 < 4; const int ci1 = dir ? (ic1 ? 3 - st1 : 35 - st1) : (ic1 ? st1 : st1 - 4);
                    const int sq1 = ic1 ? T_LAT + b * CTXL : b * SEQ, L1 = ic1 ? CTXL : SEQ, t1 = 64 * ci1;
                    const int li0 = ut, li1 = ut + 256;
                    { const int row = li0 / 6, part = li0 % 6, ts = t1 - 2 + row; if (ts >= 0 && ts < L1) pf0 = *(const unsigned*)(P + (size_t)(sq1 + ts) * GDN_W + (part >> 1) * 1024 + hd * 128 + (part & 1) * 64); }
                    if (li1 < 402) { const int row = li1 / 6, part = li1 % 6, ts = t1 - 2 + row; if (ts >= 0 && ts < L1) pf1 = *(const unsigned*)(P + (size_t)(sq1 + ts) * GDN_W + (part >> 1) * 1024 + hd * 128 + (part & 1) * 64); }
                }
            }
#endif
            __syncthreads();
#ifndef GDN_NOTILES
            {
                const LAS unsigned char* Qm = U + GU_Q; const LAS unsigned char* Km = U + GU_K;
                if (w4 < 3) {
                    const int jt = (w4 == 2) ? 1 : 0, it = (w4 == 0) ? 0 : 1;
                    f32x16 c = tile_nt(Km + 32 * jt * GP, Qm + 32 * it * GP, l31, h);
                    const int i = 32 * it + l31; const float gi = SC[i]; const int im = i - 4 * h + zs - 32 * jt;
#pragma unroll
                    for (int r = 0; r < 16; ++r) { const int c0 = (r & 3) + 8 * (r >> 2); const float ar = fminf(gi - SCh[32 * jt + c0], 0.f); c[r] = (c0 <= im) ? c[r] * __expf(ar) : 0.f; }
                    *(LAS bf16x8*)(U + GU_ATT + ((w4 * 2 + 0) * 64 + lane) * 16) = pack_step<0>(c);
                    *(LAS bf16x8*)(U + GU_ATT + ((w4 * 2 + 1) * 64 + lane) * 16) = pack_step<1>(c);
                }
                if (w4 == 0) {
                    f32x16 c = tile_nt(Km, Km + 32 * GP, l31, h);
                    const int i = 32 + l31; const float gi = SC[i], bi = SC[64 + i];
#pragma unroll
                    for (int r = 0; r < 16; ++r) { const int c0 = (r & 3) + 8 * (r >> 2); const float ar = fminf(gi - SCh[c0], 0.f); c[r] = bi * c[r] * __expf(ar); }
                    *(LAS bf16x8*)(U + GU_M10 + (0 * 64 + lane) * 16) = pack_step<0>(c);
                    *(LAS bf16x8*)(U + GU_M10 + (1 * 64 + lane) * 16) = pack_step<1>(c);
                }
                if (w4 == 1 || w4 == 3) {
                    const int ti = (w4 == 3) ? 0 : 1, tj = ti;
                    f32x16 c = tile_nt(Km + 32 * ti * GP, Km + 32 * tj * GP, l31, h);
                    const int j = 32 * tj + l31; const float gj = SC[j]; const int jm = j - 4 * h + zs - 32 * ti;
                    LAS unsigned char* mb = U + GU_M + (32 * ti + 4 * h) * GP + j * 4 + zs;
#pragma unroll
                    for (int r = 0; r < 16; ++r) { const int c0 = (r & 3) + 8 * (r >> 2); const float ar = fminf(SCh[32 * ti + c0] - gj, 0.f); const float mv = (c0 > jm) ? SCh[64 + 32 * ti + c0] * c[r] * __expf(ar) : 0.f;
                        *(LAS float*)(mb + c0 * GP) = mv; }
                    { const int i = 32 * ti + l31; const float gi = SC[i], bi = SC[64 + i]; f32x16 cc;
#pragma unroll
                      for (int r = 0; r < 16; ++r) { const int c0 = (r & 3) + 8 * (r >> 2); const float ar = fminf(gi - SCh[32 * ti + c0], 0.f); cc[r] = (r < 8 && l31 >= 16) ? bi * c[r] * __expf(ar) : 0.f; }
                      *(LAS bf16x8*)(U + GU_M10 + ((2 + ti) * 64 + lane) * 16) = pack_step<0>(cc); }
                }
            }
#endif
            __syncthreads();
            __builtin_amdgcn_sched_barrier(0);
            f32x16 R[2];
#pragma unroll
            for (int t = 0; t < 2; ++t)
#pragma unroll
                for (int r = 0; r < 16; ++r) R[t][r] = 0.f;
#define GD_KS(DT, SS) do { const bf16x8 sf = pack_step<SS>(S[DT]); const int dcol = (32 * (DT) + 16 * (SS) + 4 * h) * 2; \
                _Pragma("unroll") for (int it = 0; it < 2; ++it) { const LAS unsigned char* rp = U + (32 * it + l31) * GP + dcol; \
                    const bf16x8 ak = cat8(*(const LAS s16x4*)(rp + GU_K), *(const LAS s16x4*)(rp + GU_K + 16)); \
                    R[it] = MFMA32(ak, sf, R[it]); } } while (0)
            GD_KS(0, 0); GD_KS(0, 1); GD_KS(1, 0); GD_KS(1, 1); GD_KS(2, 0); GD_KS(2, 1); GD_KS(3, 0); GD_KS(3, 1);
#undef GD_KS
            __builtin_amdgcn_sched_barrier(0);
            f32x16 X[2];
#pragma unroll
            for (int t = 0; t < 2; ++t)
#pragma unroll
                for (int r = 0; r < 16; ++r) { const int c0 = 32 * t + (r & 3) + 8 * (r >> 2); const float vv = bf2f(*(const LAS bf16_t*)(U + GU_V + 4 * h * GP + (e0 + l31) * 2 + zs + c0 * GP)); const float eg = SCh[128 + c0];
                    X[t][r] = SCh[64 + c0] * (vv - eg * R[t][r]); }
#ifndef GDN_NOSTAGE
            asm volatile("" :: "v"(pf0), "v"(pf1));
#endif
            asm volatile("" : "+v"(X[0]), "+v"(X[1]));
            __builtin_amdgcn_sched_barrier(0);
#ifndef GDN_NOSOLVE
            {
                const LAS unsigned char* Mh = U + GU_M + 4 * h * GP;
                float xs[2][16];
#pragma unroll
                for (int t_ = 0; t_ < 2; ++t_)
#pragma unroll
                    for (int r_ = 0; r_ < 16; ++r_) xs[t_][r_] = X[t_][r_];
                int zdep = 0;
#pragma unroll
                for (int G = 0; G < 16; ++G) {
                    const int t = G >> 3, rb = 4 * ((G >> 1) & 3), hG = G & 1, i0 = 4 * G;
                    {
                        const bool own = (h == hG);
                        const LAS unsigned char* mp = U + GU_M + i0 * GP + i0 * 4 + zdep;
                        const float m10 = *(const LAS float*)(mp + GP); const f32x2 m2 = *(const LAS f32x2*)(mp + 2 * GP); const f32x4 m3 = *(const LAS f32x4*)(mp + 3 * GP);
                        const float n1 = xs[t][rb + 1] - m10 * xs[t][rb]; xs[t][rb + 1] = own ? n1 : xs[t][rb + 1];
                        const float n2 = xs[t][rb + 2] - (m2[0] * xs[t][rb] + m2[1] * xs[t][rb + 1]); xs[t][rb + 2] = own ? n2 : xs[t][rb + 2];
                        const float n3 = xs[t][rb + 3] - (m3[0] * xs[t][rb] + m3[1] * xs[t][rb + 1] + m3[2] * xs[t][rb + 2]); xs[t][rb + 3] = own ? n3 : xs[t][rb + 3];
                    }
                    __builtin_amdgcn_sched_barrier(0);
                    float v0 = xs[t][rb], v1 = xs[t][rb + 1], v2 = xs[t][rb + 2], v3 = xs[t][rb + 3];
                    const float o0 = swp_other(v0, h), o1 = swp_other(v1, h), o2 = swp_other(v2, h), o3 = swp_other(v3, h);
                    v0 = (h != hG) ? o0 : v0; v1 = (h != hG) ? o1 : v1; v2 = (h != hG) ? o2 : v2; v3 = (h != hG) ? o3 : v3;
                    asm volatile("v_and_b32 %0, 0, %1" : "=v"(zdep) : "v"(v3));
#pragma unroll
                    for (int tt = 0; tt < 2; ++tt)
#pragma unroll
                        for (int rg = 0; rg < 4; ++rg) {
                            const int Gb = 8 * tt + 2 * rg;
                            if (Gb >= G && ((Gb >> 2) == (G >> 2))) {
                                const LAS unsigned char* Mz = Mh + zdep;
                                const bool upd = (Gb > G) || (h == 1);
#pragma unroll
                                for (int a = 0; a < 4; ++a) { const f32x4 mm = *(const LAS f32x4*)(Mz + (32 * tt + 8 * rg + a) * GP + i0 * 4);
                                    const float nv = xs[tt][4 * rg + a] - ((mm[0] * v0 + mm[1] * v1) + (mm[2] * v2 + mm[3] * v3)); xs[tt][4 * rg + a] = upd ? nv : xs[tt][4 * rg + a]; }
                                if (rg == 3) asm volatile("v_and_b32 %0, 0, %1" : "=v"(zdep) : "v"(xs[tt][15]), "v"(xs[tt][14]), "v"(xs[tt][13]), "v"(xs[tt][12]), "v"(xs[tt][11]), "v"(xs[tt][10]), "v"(xs[tt][9]), "v"(xs[tt][8]), "v"(xs[tt][7]), "v"(xs[tt][6]), "v"(xs[tt][5]), "v"(xs[tt][4]), "v"(xs[tt][3]), "v"(xs[tt][2]), "v"(xs[tt][1]), "v"(xs[tt][0]));
                            }
                        }
                    if (G == 3 || G == 11) {
                        const int tq = G >> 3; f32x16 xb, ab;
#pragma unroll
                        for (int r_ = 0; r_ < 16; ++r_) { xb[r_] = xs[tq][r_]; ab[r_] = 0.f; }
                        ab = MFMA32(*(const LAS bf16x8*)(U + GU_M10 + (2 + tq) * 1024 + lane * 16 + zdep), pack_step<0>(xb), ab);
#pragma unroll
                        for (int r_ = 0; r_ < 16; ++r_) xs[tq][r_] -= ab[r_];
                    }
                    if (G == 7) {
                        f32x16 x0, a10;
#pragma unroll
                        for (int r_ = 0; r_ < 16; ++r_) { x0[r_] = xs[0][r_]; a10[r_] = 0.f; }
                        const LAS unsigned char* mf = U + GU_M10 + lane * 16 + zdep;
                        a10 = MFMA32(*(const LAS bf16x8*)(mf), pack_step<0>(x0), a10);
                        a10 = MFMA32(*(const LAS bf16x8*)(mf + 1024), pack_step<1>(x0), a10);
#pragma unroll
                        for (int r_ = 0; r_ < 16; ++r_) xs[1][r_] -= a10[r_];
                    }
                }
#pragma unroll
                for (int t_ = 0; t_ < 2; ++t_)
#pragma unroll
                    for (int r_ = 0; r_ < 16; ++r_) X[t_][r_] = xs[t_][r_];
            }
#endif
            __builtin_amdgcn_sched_barrier(0);
#ifndef GDN_NOPOST
            {
                int zs2; asm volatile("v_and_b32 %0, 0, %1" : "=v"(zs2) : "v"(X[1][15]));
                const LAS float* SCh2 = (const LAS float*)((const LAS unsigned char*)(SC + 4 * h) + zs2);
                const LAS unsigned char* U2 = U + zs2;
                asm volatile("" : "+v"(S[0]), "+v"(S[1]), "+v"(S[2]), "+v"(S[3]));
                f32x16 Oq[2];
#pragma unroll
                for (int t = 0; t < 2; ++t)
#pragma unroll
                    for (int r = 0; r < 16; ++r) Oq[t][r] = 0.f;
#define GD_QS(DT, SS) do { const bf16x8 sf = pack_step<SS>(S[DT]); const int dcol = (32 * (DT) + 16 * (SS) + 4 * h) * 2; \
                _Pragma("unroll") for (int it = 0; it < 2; ++it) { const LAS unsigned char* rp = U2 + (32 * it + l31) * GP + dcol; \
                    const bf16x8 aq = cat8(*(const LAS s16x4*)(rp + GU_Q), *(const LAS s16x4*)(rp + GU_Q + 16)); \
                    Oq[it] = MFMA32(aq, sf, Oq[it]); } } while (0)
                GD_QS(0, 0); GD_QS(0, 1); GD_QS(1, 0); GD_QS(1, 1); GD_QS(2, 0); GD_QS(2, 1); GD_QS(3, 0); GD_QS(3, 1);
#undef GD_QS
#pragma unroll
                for (int t = 0; t < 2; ++t)
#pragma unroll
                    for (int r = 0; r < 16; ++r) Oq[t][r] *= SCh2[128 + 32 * t + (r & 3) + 8 * (r >> 2)];
                const bf16x8 vf0 = pack_step<0>(X[0]), vf1 = pack_step<1>(X[0]), vf2 = pack_step<0>(X[1]), vf3 = pack_step<1>(X[1]);
                const LAS unsigned char* at = U2 + GU_ATT + lane * 16;
                Oq[0] = MFMA32(*(const LAS bf16x8*)(at + 0 * 1024), vf0, Oq[0]); Oq[0] = MFMA32(*(const LAS bf16x8*)(at + 1 * 1024), vf1, Oq[0]);
                Oq[1] = MFMA32(*(const LAS bf16x8*)(at + 2 * 1024), vf0, Oq[1]); Oq[1] = MFMA32(*(const LAS bf16x8*)(at + 3 * 1024), vf1, Oq[1]);
                Oq[1] = MFMA32(*(const LAS bf16x8*)(at + 4 * 1024), vf2, Oq[1]); Oq[1] = MFMA32(*(const LAS bf16x8*)(at + 5 * 1024), vf3, Oq[1]);
                const int sdm = dir ? -DM : DM;
                bf16_t* ob = Od + (size_t)(seq0 + t0 + (dir ? 63 - 4 * h : 4 * h)) * DM + hd * 128 + e0 + l31;
#pragma unroll
                for (int t = 0; t < 2; ++t)
#pragma unroll
                    for (int rg = 0; rg < 4; ++rg) { bf16_t* pg = ob + (32 * t + 8 * rg) * sdm;
#pragma unroll
                        for (int a = 0; a < 4; ++a) __builtin_nontemporal_store(f2bf(Oq[t][4 * rg + a]), pg + a * sdm); }
            }
            __builtin_amdgcn_sched_barrier(0);
            {
                int zs3; asm volatile("v_and_b32 %0, 0, %1" : "=v"(zs3) : "v"(X[0][0]));
                const LAS float* SCh3 = (const LAS float*)((const LAS unsigned char*)(SC + 4 * h) + zs3);
                const float gl = SC[128 + 63];
#pragma unroll
                for (int t = 0; t < 4; ++t)
#pragma unroll
                    for (int r = 0; r < 16; ++r) S[t][r] *= gl;
#pragma unroll
                for (int t = 0; t < 2; ++t)
#pragma unroll
                    for (int r = 0; r < 16; ++r) X[t][r] *= SCh3[192 + 32 * t + (r & 3) + 8 * (r >> 2)];
                const bf16x8 vf[4] = {pack_step<0>(X[0]), pack_step<1>(X[0]), pack_step<0>(X[1]), pack_step<1>(X[1])};
                const LAS unsigned char* kt = U + GU_K + (4 * h + q4) * GP + (16 * blk + 4 * p4) * 2 + zs3;
#pragma unroll
                for (int jk = 0; jk < 4; ++jk) {
                    const int ib = 32 * (jk >> 1) + 16 * (jk & 1);
#pragma unroll
                    for (int dt = 0; dt < 4; ++dt) { const s16x4 lo = tr_read(kt + ib * GP + dt * 64), hi = tr_read(kt + (ib + 8) * GP + dt * 64); S[dt] = MFMA32(cat8(lo, hi), vf[jk], S[dt]); }
                }
            }
#else
            S[0][0] += X[0][0] + X[1][15]; S[1][3] += X[0][7];
#endif
            __syncthreads();
        }
    }
}

DI void gdn_readout_phase(const Ctx& F, int l, int Mrows) {
    PHASE_IDS
    const int i2 = l >> 1; const bf16_t* P = (const bf16_t*)(F.ws + WS_BIG); bf16_t* Of = (bf16_t*)(F.ws + WS_H); const bf16_t* Ob = (const bf16_t*)(F.ws + WS_Y);
    const f32x4 gg = *(const f32x4*)(F.in[I_GNORM] + i2 * 128 + ((4 * LANE) & 127));
    const int rpw = (Mrows + F.ngw - 1) / F.ngw, mb = F.gw * rpw, me = (mb + rpw < Mrows) ? mb + rpw : Mrows;
    if (mb >= me) return;
    u32x2 an[4], bn[4], zn[4];
#define RO_FETCH(m_) do { const u32x2* ofp_ = (const u32x2*)(Of + (size_t)(m_) * DM) + LANE; const u32x2* obp_ = (const u32x2*)(Ob + (size_t)(m_) * DM) + LANE; const u32x2* zp_ = (const u32x2*)(P + (size_t)(m_) * GDN_W + 3072) + LANE; \
        _Pragma("unroll") for (int j = 0; j < 4; ++j) { an[j] = __builtin_nontemporal_load(ofp_ + 64 * j); bn[j] = __builtin_nontemporal_load(obp_ + 64 * j); zn[j] = __builtin_nontemporal_load(zp_ + 64 * j); } } while (0)
    RO_FETCH(mb);
    for (int m = mb; m < me; ++m) {
        u32x2 av[4], bv[4], zv[4];
#pragma unroll
        for (int j = 0; j < 4; ++j) { av[j] = an[j]; bv[j] = bn[j]; zv[j] = zn[j]; }
        if (m + 1 < me) RO_FETCH(m + 1);
        u32x2* ofp = (u32x2*)(Of + (size_t)m * DM) + LANE;
#pragma unroll
        for (int j = 0; j < 4; ++j) {
            const u32x2 a = av[j], bq = bv[j], z = zv[j];
            f32x4 o = (f32x4){bflo(a.x) + bflo(bq.x), bfhi(a.x) + bfhi(bq.x), bflo(a.y) + bflo(bq.y), bfhi(a.y) + bfhi(bq.y)};
            float ss = (o[0] * o[0] + o[1] * o[1]) + (o[2] * o[2] + o[3] * o[3]);
            ss += shx<1>(ss); ss += shx<2>(ss); ss += shx<4>(ss); ss += shx<8>(ss); ss += shx<16>(ss);
            const float rs = rsqrtf(ss * (1.0f / 128.0f) + RMS_EPS);
            const f32x4 zz = (f32x4){bflo(z.x), bfhi(z.x), bflo(z.y), bfhi(z.y)};
            u32x2 w; w.x = cvt_pk_bf16(o[0] * rs * gg[0] * silu_f(zz[0]), o[1] * rs * gg[1] * silu_f(zz[1])); w.y = cvt_pk_bf16(o[2] * rs * gg[2] * silu_f(zz[2]), o[3] * rs * gg[3] * silu_f(zz[3]));
            ofp[64 * j] = w;
        }
    }
#undef RO_FETCH
}
#define XB_TMO      128
#define XB_XCNT(j)  (256  + 64 * (j))
#define XB_XSUB(j)  (1280 + 64 * (j))
#define XB_XGEN(j)  (2304 + 64 * (j))
#define XB_TOP      3328
#define XB_TOPGEN   3392
#define XCD_BAR_WORDS 3456
#define XB_SPIN_CAP (1u << 24)

__device__ __forceinline__ unsigned xb_ld(unsigned* p)              { return __hip_atomic_load(p, __ATOMIC_RELAXED, __HIP_MEMORY_SCOPE_AGENT); }
__device__ __forceinline__ unsigned xb_add(unsigned* p, unsigned v) { return __hip_atomic_fetch_add(p, v, __ATOMIC_RELAXED, __HIP_MEMORY_SCOPE_AGENT); }
__device__ __forceinline__ unsigned xb_xcc_id() { return (unsigned)__builtin_amdgcn_s_getreg((3 << 11) | 20) & 0xFu; }
#define XB_SPIN(cond, bar) do { unsigned _sp = 0; while (cond) { __builtin_amdgcn_s_sleep(1); \
    if ((++_sp & 255u) == 0u) { if (xb_ld(&(bar)[XB_TMO])) break; if (_sp > XB_SPIN_CAP) { atomicAdd(&(bar)[XB_TMO], 1u); break; } } } } while (0)

struct XcdBarrier {
    unsigned* bar; unsigned x;
    volatile LAS unsigned* st;
};

__device__ __forceinline__ XcdBarrier xcd_barrier_post(unsigned* bar, volatile LAS unsigned* st) {
    XcdBarrier b; b.bar = bar; b.x = xb_xcc_id(); b.st = st;
    if (threadIdx.x == 0) (void)xb_add(&bar[XB_XCNT(b.x)], 1u);
    return b;
}
__device__ __forceinline__ void xcd_barrier_complete(unsigned* bar, unsigned x, unsigned& nloc, unsigned& nx) {
    const unsigned G = gridDim.x * gridDim.y * gridDim.z;
    unsigned sum, cnt, mine, sp = 0u;
    for (;;) {
        sum = 0u; cnt = 0u; mine = 0u;
#pragma unroll
        for (unsigned j = 0; j < 16; ++j) { const unsigned c = xb_ld(&bar[XB_XCNT(j)]); sum += c; cnt += (c > 0u) ? 1u : 0u; mine = (j == x) ? c : mine; }
        if (sum == G) break;
        __builtin_amdgcn_s_sleep(1);
        if ((++sp & 255u) == 0u) { if (xb_ld(&bar[XB_TMO])) break; if (sp > XB_SPIN_CAP) { atomicAdd(&bar[XB_TMO], 1u); break; } }
    }
    nloc = mine > 0u ? mine : 1u; nx = cnt > 0u ? cnt : 1u;
}

__device__ __forceinline__ void xcd_barrier(const XcdBarrier& b) {
    asm volatile("s_waitcnt vmcnt(0)" ::: "memory");
    __syncthreads();
    if (threadIdx.x == 0) {
        unsigned* bar = b.bar;
        __builtin_amdgcn_s_waitcnt(0);
        unsigned nloc = b.st[0], nx = b.st[1];
        if (nloc == 0u) { xcd_barrier_complete(bar, b.x, nloc, nx); b.st[0] = nloc; b.st[1] = nx; }
        const unsigned old = xb_add(&bar[XB_XSUB(b.x)], 1u);
        const unsigned gen = old / nloc;
        if (old + 1u == (gen + 1u) * nloc) {
            __builtin_amdgcn_fence(__ATOMIC_RELEASE, "agent");
            asm volatile("s_waitcnt vmcnt(0)" ::: "memory");
            const unsigned og = xb_add(&bar[XB_TOP], 1u);
            const unsigned tg = og / nx;
            if (og + 1u == (tg + 1u) * nx) xb_add(&bar[XB_TOPGEN], 1u);
            else XB_SPIN(xb_ld(&bar[XB_TOPGEN]) == tg, bar);
            __builtin_amdgcn_fence(__ATOMIC_ACQUIRE, "agent");
            xb_add(&bar[XB_XGEN(b.x)], 1u);
            asm volatile("s_waitcnt vmcnt(0)" ::: "memory");
        } else {
            XB_SPIN(xb_ld(&bar[XB_XGEN(b.x)]) == gen, bar);
            __builtin_amdgcn_fence(__ATOMIC_ACQUIRE, "agent");
            asm volatile("s_waitcnt vmcnt(0)" ::: "memory");
        }
    }
    __syncthreads();
}

template <class Epi> DI void run_gemm(const Ctx& F, const bf16_t* A, const bf16_t* Bt, int M, int N, int K, const Epi& E) {
    pg8::Gemm g{A, Bt, M, N, K}; pg8::StaticOrder S; S.init(M, N, F.G, (int)blockIdx.x);
    pg8::gemm_phase<Epi, pg8::StaticOrder, Epi::ALIGN, true>(F.lds, g, S, E, F.wave);
}
constexpr int N_PHASES = 2 + 8 * 4;
#ifndef ENMASK
#define ENMASK 0xff
#endif
#define EN(k) (((ENMASK) >> (k)) & 1)
#ifndef PROBE_DUP
#define PROBE_DUP 0
#endif
#define DUP(k) ((((PROBE_DUP) >> (k)) & 1) ? 2 : 1)
__global__ void __launch_bounds__(NTHREADS, 2) mk_fwd(Args args) {
    extern __shared__ __attribute__((aligned(16))) unsigned char lds_raw[];
    cg::grid_group grid = cg::this_grid();
    volatile LAS unsigned* bar_st = (volatile LAS unsigned*)((LAS unsigned char*)lds_raw + LDS_BYTES - 16);
    if (threadIdx.x == 0) { bar_st[0] = 0u; bar_st[1] = 0u; }
    __syncthreads();
    XcdBarrier xbar = xcd_barrier_post((unsigned*)(args.ws + WS_BAR), bar_st);
    Ctx F;
    F.in = (const float* const __attribute__((address_space(4)))*)__builtin_amdgcn_kernarg_segment_ptr();
    F.out = args.out; F.ws = args.ws; F.lds = (LAS unsigned char*)lds_raw;
    const int wave0 = __builtin_amdgcn_readfirstlane((int)threadIdx.x >> 6);
    F.wave = 0; F.gw = 0; F.G = gridDim.x; F.ngw = F.G * NWAVES;
    bf16_t *H, *Y, *BIG; const bf16_t *win_t, *wout_t, *wgu_t, *wdn_t;
    for (int ph = args.ph_lo; ph < args.ph_hi; ++ph) {
        {
            unsigned char* ws_o = args.ws; float* out_o = args.out; int wv_o = wave0; asm volatile("" : "+s"(ws_o), "+s"(out_o), "+s"(wv_o));
            F.wave = wv_o; F.gw = blockIdx.x * NWAVES + F.wave; F.ws = ws_o; F.out = out_o;
            H = (bf16_t*)(F.ws + WS_H); Y = (bf16_t*)(F.ws + WS_Y); BIG = (bf16_t*)(F.ws + WS_BIG);
            win_t = (const bf16_t*)(F.ws + WS_WIN); wout_t = (const bf16_t*)(F.ws + WS_WOUT); wgu_t = (const bf16_t*)(F.ws + WS_WGU); wdn_t = (const bf16_t*)(F.ws + WS_WDN);
        }
        if (ph == 0) { for (int rep = 0; rep < DUP(3); ++rep) { if (EN(0)) modvec_phase(F); if (EN(1)) wconv_layer(F, 0); if (rep + 1 < DUP(3)) grid.sync(); } }
        else if (ph == 1) { for (int rep = 0; rep < DUP(4); ++rep) { if (EN(2)) rowwise_phase(F, 0, 0, T_ALL); if (rep + 1 < DUP(4)) grid.sync(); } }
        else {
            const int l = (ph - 2) >> 3, sub = (ph - 2) & 7; const bool odd = l & 1; const int Mr = (l == 3) ? T_LAT : T_ALL;
            int gk = 0, gM = 0, gN = 0, gK = 0, gld = 0; const bf16_t* gA = nullptr; const bf16_t* gB = nullptr; bf16_t* gO = nullptr;
            switch (sub) {
            case 0: gk = 1; gA = H; gB = win_t; gO = BIG; gM = T_ALL; gN = odd ? GDN_W : ATT_W; gK = DM; gld = gN; break;
            case 1: if (odd) { if (EN(6)) for (int rep = 0; rep < DUP(2); ++rep) { gdn_scan_phase(F, l); if (rep + 1 < DUP(2)) grid.sync(); } } else { if (EN(4)) attn_prep_phase(F, l >> 1); } break;
            case 2: if (odd) { if (EN(7)) gdn_readout_phase(F, l, Mr); } else { if (EN(5)) for (int rep = 0; rep < DUP(1); ++rep) { attn_phase(F, l); if (rep + 1 < DUP(1)) grid.sync(); } } break;
            case 3: gk = 1; gA = H; gB = wout_t; gO = Y; gM = Mr; gN = DM; gK = DM; gld = DM; break;
            case 4: if (EN(2)) rowwise_phase(F, 1, l, Mr); break;
            case 5: gk = 2; gA = H; gB = wgu_t; gO = BIG; gM = Mr; gN = 2 * FFH; gK = DM; gld = FFH; break;
            case 6: gk = 1; gA = BIG; gB = wdn_t; gO = Y; gM = Mr; gN = DM; gK = FFH; gld = DM; break;
            default: if (EN(2)) rowwise_phase(F, 2, l, Mr); if (EN(1) && l < 3) wconv_layer(F, l + 1); break;
            }
            if (EN(3)) for (int rep = 0; rep < DUP(0); ++rep) {
                if (gk == 1) { pg8::EpiStore E{gO, gld, (sub == 0 && !odd) ? 1 : 0}; run_gemm(F, gA, gB, gM, gN, gK, E); }
                else if (gk == 2) { pg8::EpiSwiglu E{gO, gld}; run_gemm(F, gA, gB, gM, gN, gK, E); }
                if (rep + 1 < DUP(0)) grid.sync();
            }
        }
        if (ph + 1 < args.ph_hi) { if (ph == args.ph_lo) grid.sync(); else xcd_barrier(xbar); if (DUP(5) == 2) xcd_barrier(xbar); }
    }
}

extern "C" void kernel_launch(void* const* d_in, const int* in_sizes, int n_in, void* d_out, int out_size, void* d_ws, size_t ws_size, hipStream_t stream) {
    static int grid = 0;
    if (grid == 0) {
        if (n_in != 20 || out_size != T_LAT * DM || ws_size < WS_END) { fprintf(stderr, "kernel_launch: unexpected problem shape (n_in %d out %d ws %zu)\n", n_in, out_size, ws_size); grid = -1; return; }
        int dev = 0, cus = 0, per_cu = 0;
        (void)hipGetDevice(&dev); (void)hipDeviceGetAttribute(&cus, hipDeviceAttributeMultiprocessorCount, dev);
        if (hipFuncSetAttribute((const void*)mk_fwd, hipFuncAttributeMaxDynamicSharedMemorySize, LDS_BYTES) != hipSuccess) { fprintf(stderr, "kernel_launch: hipFuncSetAttribute failed\n"); grid = -1; return; }
        if (hipOccupancyMaxActiveBlocksPerMultiprocessor(&per_cu, (const void*)mk_fwd, NTHREADS, LDS_BYTES) != hipSuccess || per_cu < 1) { fprintf(stderr, "kernel_launch: occupancy query says %d\n", per_cu); per_cu = 1; }
        (void)hipGetLastError();
        grid = cus * per_cu;
    }
    if (grid < 0) return;
    if (hipMemsetAsync((char*)d_ws + WS_BAR, 0, XCD_BAR_WORDS * 4, stream) != hipSuccess) { fprintf(stderr, "kernel_launch: memset of the barrier words failed\n"); return; }
    Args a{};
    for (int i = 0; i < 20; ++i) a.in[i] = (const float*)d_in[i];
    a.out = (float*)d_out; a.ws = (unsigned char*)d_ws; a.ph_lo = 0; a.ph_hi = N_PHASES;
    void* kargs[] = {&a};
    hipError_t e = hipLaunchCooperativeKernel((const void*)mk_fwd, dim3(grid), dim3(NTHREADS), kargs, LDS_BYTES, stream);
    if (e != hipSuccess) fprintf(stderr, "cooperative launch failed: %s (grid %d)\n", hipGetErrorString(e), grid);
}
```

```cpp
#include <hip/hip_runtime.h>
#include <hip/hip_cooperative_groups.h>
#include <cstdio>
#include <cstdint>
namespace cg = cooperative_groups;
namespace pg8 {
#define PG8_LAS __attribute__((address_space(3)))
typedef unsigned short bf16_t;
typedef short bf16x8 __attribute__((ext_vector_type(8)));
typedef float f32x4 __attribute__((ext_vector_type(4)));
typedef unsigned u32x4 __attribute__((ext_vector_type(4)));
constexpr int BM = 256, BK = 64, HALF = 128, HTB = HALF * BK * 2  , STAGE_BYTES = 8 * HTB, NXCD = 8, WGM = 8;

__host__ __device__ __forceinline__ int lds_byte(int r, int c) { const int st = (r >> 4) * 2 + (c >> 5), rr = r & 15, cc = c & 31, ob = rr * 64 + cc * 2; return st * 1024 + (ob ^ (((ob >> 9) & 1) << 5)); }
__host__ __device__ __forceinline__ void stage_rc(int b, int& R, int& C) { const int st = b / 1024, sb = b % 1024, swz = sb ^ (((sb >> 9) & 1) << 5); R = (st >> 1) * 16 + swz / 64; C = (st & 1) * 32 + (swz % 64) / 2; }
__host__ __device__ __forceinline__ int perm32(int rho) { const int n = rho >> 4, i = rho & 15; return 8 * (i >> 2) + 4 * n + (i & 3); }

struct Unit { int pm, pn; };
struct Gemm { const bf16_t* A; const bf16_t* Bt; int M, N, K; };

struct StaticOrder {
    int nM, nN, nwg, G, c;
    __host__ __device__ void init(int M, int N, int G_, int c_) { nM = M / BM; nN = N / BM; nwg = nM * nN; G = G_; c = c_; }
    __host__ __device__ bool next(int i, Unit& u) const {
        const long L = (long)i * G + c; if (L >= nwg) return false;
        int wgid = (int)L; { const int q = nwg / NXCD, r = nwg % NXCD, xcd = wgid % NXCD, off = wgid / NXCD; wgid = (xcd < r ? xcd * (q + 1) : r * (q + 1) + (xcd - r) * q) + off; }
        const int nig = WGM * nN, gid = wgid / nig, fm = gid * WGM, gsz = (nM - fm) < WGM ? (nM - fm) : WGM;
        u.pm = fm + ((wgid % nig) % gsz); u.pn = (wgid % nig) / gsz; return true;
    }
    __device__ __forceinline__ void a_ready(const Unit&) const {}
    __device__ __forceinline__ void done(const Unit&) const {}
};

typedef float f32x2 __attribute__((ext_vector_type(2)));
typedef __bf16 bf16x2_t __attribute__((ext_vector_type(2)));
__device__ __forceinline__ unsigned cvt_pk_bf16(float lo, float hi) { f32x2 v = {lo, hi}; bf16x2_t b = __builtin_convertvector(v, bf16x2_t); return __builtin_bit_cast(unsigned, b); }
__device__ __forceinline__ float silu_f(float x) { return x * __builtin_amdgcn_rcpf(1.0f + __expf(-x)); }
__device__ __forceinline__ float lane32_other(float v, int hh) { auto rr = __builtin_amdgcn_permlane32_swap(__builtin_bit_cast(unsigned, v), __builtin_bit_cast(unsigned, v), false, false); return __builtin_bit_cast(float, hh ? rr[0] : rr[1]); }
struct EpiStore {
    static constexpr bool PERM = true, AFTER_DRAIN = false, ALIGN = true;
    bf16_t* O; int ldc; int rope;
    __device__ __forceinline__ void operator()(const f32x4 (&acc)[2][2][4][2], const Unit& u, int wr, int wc, int fr, int fq) const {
        const int row0 = u.pm * BM + wr * 64 + fr; const int col0 = u.pn * BM + wc * 32 + 8 * fq;
        const bool dorope = rope && (u.pn == 2 || u.pn == 3) && (u.pm * BM < 65536);
        float invf[8];
#pragma unroll
        for (int j = 0; j < 8; ++j) invf[j] = __builtin_amdgcn_exp2f(-(float)(2 * (8 * (fq & 1) + j)) * (13.287712379549449f / 32.0f));
        const float sgn = (fq & 2) ? 1.0f : -1.0f;
#pragma unroll
        for (int ai = 0; ai < 2; ++ai)
#pragma unroll
            for (int m = 0; m < 4; ++m) { const int row = row0 + ai * HALF + m * 16; bf16_t* rowp = O + (size_t)row * ldc + col0;
                float cs[8], sn[8];
                if (dorope) { const int t = row & 2047; const float pos = (float)((wc & 1) ? (t & 63) : (t >> 6));
#pragma unroll
                    for (int j = 0; j < 8; ++j) { cs[j] = __cosf(pos * invf[j]); sn[j] = __sinf(pos * invf[j]); } }
#pragma unroll
                for (int bj = 0; bj < 2; ++bj) { f32x4 v0 = acc[ai][bj][m][0], v1 = acc[ai][bj][m][1];
                    if (dorope) {
#pragma unroll
                        for (int j = 0; j < 4; ++j) { const float p0 = lane32_other(v0[j], fq >> 1), p1 = lane32_other(v1[j], fq >> 1);
                            v0[j] = v0[j] * cs[j] + sgn * p0 * sn[j]; v1[j] = v1[j] * cs[4 + j] + sgn * p1 * sn[4 + j]; } }
                    u32x4 w; w.x = cvt_pk_bf16(v0[0], v0[1]); w.y = cvt_pk_bf16(v0[2], v0[3]); w.z = cvt_pk_bf16(v1[0], v1[1]); w.w = cvt_pk_bf16(v1[2], v1[3]);
                    *(u32x4*)(rowp + bj * HALF) = w; } }
    }
};
struct EpiSwiglu {
    static constexpr bool PERM = true, AFTER_DRAIN = false, ALIGN = true;
    bf16_t* O; int ldc;
    __device__ __forceinline__ void operator()(const f32x4 (&acc)[2][2][4][2], const Unit& u, int wr, int wc, int fr, int fq) const {
        const int row0 = u.pm * BM + wr * 64 + fr; const int col0 = u.pn * HALF + wc * 32 + 8 * fq;
#pragma unroll
        for (int ai = 0; ai < 2; ++ai)
#pragma unroll
            for (int m = 0; m < 4; ++m) { bf16_t* rowp = O + (size_t)(row0 + ai * HALF + m * 16) * ldc + col0;
                const f32x4 g0 = acc[ai][0][m][0], g1 = acc[ai][0][m][1], u0 = acc[ai][1][m][0], u1 = acc[ai][1][m][1];
                u32x4 w; w.x = cvt_pk_bf16(silu_f(g0[0]) * u0[0], silu_f(g0[1]) * u0[1]); w.y = cvt_pk_bf16(silu_f(g0[2]) * u0[2], silu_f(g0[3]) * u0[3]);
                w.z = cvt_pk_bf16(silu_f(g1[0]) * u1[0], silu_f(g1[1]) * u1[1]); w.w = cvt_pk_bf16(silu_f(g1[2]) * u1[2], silu_f(g1[3]) * u1[3]);
                __builtin_nontemporal_store(w, (u32x4*)rowp); }
    }
};

template <class Epi, class Sched, bool ALIGN_EPI = false, bool SP2 = false>
__device__ __forceinline__ void gemm_phase(PG8_LAS unsigned char* lds, const Gemm g, const Sched& S, const Epi& E, int wave_id) {
    int lane_; asm volatile("v_mbcnt_lo_u32_b32 %0, -1, 0\n\tv_mbcnt_hi_u32_b32 %0, -1, %0" : "=v"(lane_)); const int tid_ = wave_id * 64 + lane_;
    const int tid = tid_, wid = __builtin_amdgcn_readfirstlane(tid >> 6), lane = tid & 63, wr = wid >> 2, wc = wid & 3, fr = lane & 15, fq = lane >> 4;
    const int K = g.K, nt = K / BK;
    unsigned voffA[2], voffB[2];
#pragma unroll
    for (int i = 0; i < 2; ++i) { int R, C; stage_rc(tid * 16 + i * 8192, R, C); const int Rb = Epi::PERM ? ((R & ~31) + perm32(R & 31)) : R;
        voffA[i] = (unsigned)(R * K + C) * 2u; voffB[i] = (unsigned)(Rb * K + C) * 2u; }
    const size_t kstep = (size_t)(BK * 2);
    const size_t hstep = (size_t)HALF * K * 2;
    const size_t tstep = 2 * hstep;
    const unsigned ldsw = (unsigned)wid * 1024u;
    const int aoff = lds_byte(wr * 64 + fr, fq * 8), boff = lds_byte(wc * 32 + fr, fq * 8);
#define PG8_SA(b, h) (((b) * 2 + (h)) * HTB)
#define PG8_SB(b, h) ((4 + (b) * 2 + (h)) * HTB)
#define PG8_STAGE(bufoff, gbase, voff) do { _Pragma("unroll") for (int _i = 0; _i < 2; ++_i) \
        __builtin_amdgcn_global_load_lds((const unsigned*)((const char*)(gbase) + (voff)[_i]), (PG8_LAS unsigned*)(lds + (bufoff) + ldsw + _i * 8192), 16, 0, 0); } while (0)
#define PG8_LDA(dst, b, h) do { _Pragma("unroll") for (int m = 0; m < 4; ++m) _Pragma("unroll") for (int k = 0; k < 2; ++k) dst[m][k] = *(const PG8_LAS bf16x8*)(lds + PG8_SA(b, h) + aoff + m * 2048 + k * 1024); } while (0)
#define PG8_LDB(dst, b, h) do { _Pragma("unroll") for (int n = 0; n < 2; ++n) _Pragma("unroll") for (int k = 0; k < 2; ++k) dst[n][k] = *(const PG8_LAS bf16x8*)(lds + PG8_SB(b, h) + boff + n * 2048 + k * 1024); } while (0)
#define PG8_MMA(ai, bj, At, Bt) do { __builtin_amdgcn_s_setprio(1); _Pragma("unroll") for (int m = 0; m < 4; ++m) _Pragma("unroll") for (int n = 0; n < 2; ++n) _Pragma("unroll") for (int k = 0; k < 2; ++k) \
        acc[ai][bj][m][n] = __builtin_amdgcn_mfma_f32_16x16x32_bf16(Bt[n][k], At[m][k], acc[ai][bj][m][n], 0, 0, 0); __builtin_amdgcn_s_setprio(0); } while (0)
#define PG8_WAIT_V(n) asm volatile("s_waitcnt vmcnt(" #n ")" ::: "memory")
#define PG8_WAIT_L(n) asm volatile("s_waitcnt lgkmcnt(" #n ")" ::: "memory")
#define PG8_BAR __builtin_amdgcn_s_barrier()
#define PG8_SCHED __builtin_amdgcn_sched_barrier(0)
    Unit cur, nxt; int ui = 0;
    if (!S.next(0, cur)) return;
    f32x4 acc[2][2][4][2];
#pragma unroll
    for (int a = 0; a < 2; ++a)
#pragma unroll
        for (int b = 0; b < 2; ++b)
#pragma unroll
            for (int m = 0; m < 4; ++m)
#pragma unroll
                for (int n = 0; n < 2; ++n) acc[a][b][m][n] = (f32x4){0.f, 0.f, 0.f, 0.f};
    bf16x8 At[4][2], B0[2][2], B1[2][2];
    const char* cA = (const char*)g.A + (size_t)cur.pm * tstep; const char* cB = (const char*)g.Bt + (size_t)cur.pn * tstep;
    S.a_ready(cur);
    if constexpr (SP2) {
        PG8_STAGE(PG8_SB(0, 0), cB, voffB); PG8_STAGE(PG8_SB(0, 1), cB + hstep, voffB); PG8_STAGE(PG8_SA(0, 0), cA, voffA); PG8_STAGE(PG8_SA(0, 1), cA + hstep, voffA);
        if (wr == 1) PG8_BAR;
        PG8_WAIT_V(2); PG8_BAR;
        PG8_STAGE(PG8_SB(1, 0), cB + kstep, voffB); PG8_STAGE(PG8_SA(1, 0), cA + kstep, voffA); PG8_STAGE(PG8_SB(1, 1), cB + hstep + kstep, voffB);
        PG8_WAIT_V(6); PG8_BAR;
    } else {
        PG8_STAGE(PG8_SB(0, 0), cB, voffB); PG8_STAGE(PG8_SA(0, 0), cA, voffA); PG8_STAGE(PG8_SB(0, 1), cB + hstep, voffB); PG8_STAGE(PG8_SA(0, 1), cA + hstep, voffA);
        if (wr == 1) PG8_BAR;
        PG8_WAIT_V(4); PG8_BAR;
        PG8_STAGE(PG8_SB(1, 0), cB + kstep, voffB); PG8_STAGE(PG8_SA(1, 0), cA + kstep, voffA); PG8_STAGE(PG8_SB(1, 1), cB + hstep + kstep, voffB);
        PG8_WAIT_V(6); PG8_BAR;
    }
    for (;;) {
        const bool has_next = S.next(ui + 1, nxt);
        const char* nA = has_next ? (const char*)g.A + (size_t)nxt.pm * tstep : cA; const char* nB = has_next ? (const char*)g.Bt + (size_t)nxt.pn * tstep : cB;
        for (int t = 0; t < nt; t += 2) {
            const bool last = (t == nt - 2);
            const char* a1 = cA + (size_t)(t + 1) * kstep;
            const char* a2 = last ? nA : cA + (size_t)(t + 2) * kstep; const char* b2 = last ? nB : cB + (size_t)(t + 2) * kstep;
            const char* a3 = a2 + kstep; const char* b3 = b2 + kstep;
            if (last && has_next) S.a_ready(nxt);
            if constexpr (SP2) {
            PG8_LDB(B0, 0, 0); PG8_LDB(B1, 0, 1); PG8_SCHED; PG8_LDA(At, 0, 0); PG8_STAGE(PG8_SA(1, 1), a1 + hstep, voffA);
            PG8_WAIT_V(8); PG8_WAIT_L(0); PG8_BAR; PG8_MMA(0, 0, At, B0); PG8_MMA(0, 1, At, B1); PG8_BAR; PG8_SCHED;
            PG8_LDA(At, 0, 1); PG8_STAGE(PG8_SB(0, 0), b2, voffB); PG8_STAGE(PG8_SB(0, 1), b2 + hstep, voffB); PG8_STAGE(PG8_SA(0, 0), a2, voffA);
            PG8_WAIT_V(8); PG8_WAIT_L(0); PG8_BAR; PG8_MMA(1, 0, At, B0); PG8_MMA(1, 1, At, B1); PG8_BAR; PG8_SCHED;
            PG8_LDB(B0, 1, 0); PG8_LDB(B1, 1, 1); PG8_SCHED; PG8_LDA(At, 1, 0); PG8_STAGE(PG8_SA(0, 1), a2 + hstep, voffA);
            PG8_WAIT_V(8); PG8_WAIT_L(0); PG8_BAR; PG8_MMA(0, 0, At, B0); PG8_MMA(0, 1, At, B1); PG8_BAR; PG8_SCHED;
            PG8_LDA(At, 1, 1); PG8_STAGE(PG8_SB(1, 0), b3, voffB); PG8_STAGE(PG8_SB(1, 1), b3 + hstep, voffB); PG8_STAGE(PG8_SA(1, 0), a3, voffA);
            PG8_WAIT_V(8); PG8_WAIT_L(0); PG8_BAR; PG8_MMA(1, 0, At, B0); PG8_MMA(1, 1, At, B1); PG8_BAR; PG8_SCHED;
            } else {
            PG8_LDB(B0, 0, 0); PG8_SCHED; PG8_LDA(At, 0, 0); PG8_STAGE(PG8_SA(1, 1), a1 + hstep, voffA);
            PG8_WAIT_L(8); PG8_BAR; PG8_WAIT_L(0); PG8_MMA(0, 0, At, B0); PG8_BAR; PG8_SCHED;
            PG8_LDB(B1, 0, 1); PG8_STAGE(PG8_SB(0, 0), b2, voffB);
            PG8_BAR; PG8_WAIT_L(0); PG8_MMA(0, 1, At, B1); PG8_BAR;
            PG8_LDA(At, 0, 1); PG8_STAGE(PG8_SA(0, 0), a2, voffA);
            PG8_BAR; PG8_WAIT_L(0); PG8_MMA(1, 0, At, B0); PG8_BAR; PG8_SCHED;
            PG8_STAGE(PG8_SB(0, 1), b2 + hstep, voffB);
            PG8_WAIT_V(6); PG8_BAR; PG8_MMA(1, 1, At, B1); PG8_BAR;
            PG8_LDB(B0, 1, 0); PG8_SCHED; PG8_LDA(At, 1, 0); PG8_STAGE(PG8_SA(0, 1), a2 + hstep, voffA);
            PG8_WAIT_L(8); PG8_BAR; PG8_WAIT_L(0); PG8_MMA(0, 0, At, B0); PG8_BAR; PG8_SCHED;
            PG8_LDB(B1, 1, 1); PG8_STAGE(PG8_SB(1, 0), b3, voffB);
            PG8_BAR; PG8_WAIT_L(0); PG8_MMA(0, 1, At, B1); PG8_BAR;
            PG8_LDA(At, 1, 1); PG8_STAGE(PG8_SA(1, 0), a3, voffA);
            PG8_BAR; PG8_WAIT_L(0); PG8_MMA(1, 0, At, B0); PG8_BAR; PG8_SCHED;
            PG8_STAGE(PG8_SB(1, 1), b3 + hstep, voffB);
            PG8_WAIT_V(6); PG8_BAR; PG8_MMA(1, 1, At, B1); PG8_BAR;
            }
        }
        if constexpr (ALIGN_EPI) { if (wr == 0) PG8_BAR; }
        if constexpr (!Epi::AFTER_DRAIN) { E(acc, cur, wr, wc, fr, fq); S.done(cur); }
        if (!has_next) break;
#pragma unroll
        for (int a = 0; a < 2; ++a)
#pragma unroll
            for (int b = 0; b < 2; ++b)
#pragma unroll
                for (int m = 0; m < 4; ++m)
#pragma unroll
                    for (int n = 0; n < 2; ++n) acc[a][b][m][n] = (f32x4){0.f, 0.f, 0.f, 0.f};
        cur = nxt; cA = nA; cB = nB; ++ui;
        if constexpr (ALIGN_EPI) { if (wr == 1) PG8_BAR; }
    }
    PG8_WAIT_V(0);
    if constexpr (!ALIGN_EPI) { if (wr == 0) PG8_BAR; }
    PG8_BAR;
    if constexpr (Epi::AFTER_DRAIN) { E.fused(acc, cur, wr, wc, fr, fq, lds, wid, lane); S.done(cur); }
#undef PG8_SA
#undef PG8_SB
#undef PG8_STAGE
#undef PG8_LDA
#undef PG8_LDB
#undef PG8_MMA
#undef PG8_WAIT_V
#undef PG8_WAIT_L
#undef PG8_BAR
#undef PG8_SCHED
}
}
#define LAS __attribute__((address_space(3)))
#define DI __device__ __forceinline__
typedef unsigned short bf16_t;
typedef short bf16x8 __attribute__((ext_vector_type(8)));
typedef short s16x4 __attribute__((ext_vector_type(4)));
typedef float f32x4 __attribute__((ext_vector_type(4)));
typedef float f32x16 __attribute__((ext_vector_type(16)));
typedef unsigned u32x4 __attribute__((ext_vector_type(4)));
typedef unsigned u32x2 __attribute__((ext_vector_type(2)));
typedef float f32x2 __attribute__((ext_vector_type(2)));
using pg8::cvt_pk_bf16;
using pg8::silu_f;

constexpr int NTHREADS = 512, NWAVES = 8;
constexpr int DM = 1024, T_LAT = 65536, T_CTX = 8192, T_ALL = T_LAT + T_CTX, SEQ = 2048, CTXL = 256, NB = 32;
constexpr int ATT_W = 2304, GDN_W = 4352, GDN_WREAL = 4128, FFH = 2816;
constexpr float RMS_EPS = 1e-6f;
constexpr int LDS_BYTES = 163840;
constexpr size_t MiB = 1u << 20;
constexpr size_t WS_BAR = 3670016;
constexpr size_t WS_MOD = 0, WS_WIN = 4 * MiB, WS_WOUT = 13 * MiB, WS_WGU = 15 * MiB, WS_WDN = 26 * MiB, WS_XCTX = 32 * MiB, WS_H = 64 * MiB, WS_Y = 208 * MiB, WS_BIG = 352 * MiB, WS_END = 964 * MiB;

struct Args { const float* in[20]; float* out; unsigned char* ws; int ph_lo, ph_hi; };
enum { I_X = 0, I_C, I_CTX, I_CCTX, I_ADAW, I_ADAB, I_NORMG, I_AWIN, I_AWOUT, I_DLAM, I_SUBLN, I_QKG, I_GWIN, I_GCONV, I_GALOG, I_GDT, I_GNORM, I_GWOUT, I_FGU, I_FDN };

DI float bf2f(bf16_t b) { return __uint_as_float((unsigned)b << 16); }
DI float bflo(unsigned u) { return __uint_as_float(u << 16); }
DI float bfhi(unsigned u) { return __uint_as_float(u & 0xffff0000u); }
DI bf16_t f2bf(float f) { return (bf16_t)(cvt_pk_bf16(f, 0.f) & 0xffffu); }
template <int OFF> DI float shx(float v) { return __int_as_float(__builtin_amdgcn_ds_swizzle(__float_as_int(v), (OFF << 10) | 0x1f)); }
DI float swp_other(float v, int h) { auto rr = __builtin_amdgcn_permlane32_swap(__float_as_uint(v), __float_as_uint(v), false, false); return __uint_as_float(h ? rr[0] : rr[1]); }
DI float swp_sum(float v) { auto rr = __builtin_amdgcn_permlane32_swap(__float_as_uint(v), __float_as_uint(v), false, false); return __uint_as_float(rr[0]) + __uint_as_float(rr[1]); }
DI float swp_max(float v) { auto rr = __builtin_amdgcn_permlane32_swap(__float_as_uint(v), __float_as_uint(v), false, false); return fmaxf(__uint_as_float(rr[0]), __uint_as_float(rr[1])); }
DI float wave_sum(float v) { v += shx<1>(v); v += shx<2>(v); v += shx<4>(v); v += shx<8>(v); v += shx<16>(v); return swp_sum(v); }
#define MFMA32(a, b, c) __builtin_amdgcn_mfma_f32_32x32x16_bf16((a), (b), (c), 0, 0, 0)
DI int crow(int r, int h) { return (r & 3) + 8 * (r >> 2) + 4 * h; }
template <int S> DI bf16x8 pack_step(const f32x16& x) {
    u32x4 p; p.x = cvt_pk_bf16(x[8 * S], x[8 * S + 1]); p.y = cvt_pk_bf16(x[8 * S + 2], x[8 * S + 3]); p.z = cvt_pk_bf16(x[8 * S + 4], x[8 * S + 5]); p.w = cvt_pk_bf16(x[8 * S + 6], x[8 * S + 7]);
    return __builtin_bit_cast(bf16x8, p);
}
typedef short v4i16_t __attribute__((ext_vector_type(4)));
DI s16x4 tr_read(LAS const unsigned char* p) { return __builtin_bit_cast(s16x4, __builtin_amdgcn_ds_read_tr16_b64_v4i16((LAS v4i16_t*)p)); }
DI bf16x8 cat8(s16x4 lo, s16x4 hi) { return __builtin_shufflevector(lo, hi, 0, 1, 2, 3, 4, 5, 6, 7); }

struct Ctx {
    const float* const __attribute__((address_space(4)))* in; float* out; unsigned char* ws;
    LAS unsigned char* lds; int wave, G, gw, ngw;
};
DI int get_lane() { int l; asm volatile("v_mbcnt_lo_u32_b32 %0, -1, 0\n\tv_mbcnt_hi_u32_b32 %0, -1, %0" : "=v"(l)); return l; }
#define PHASE_IDS const int LANE = get_lane(); const int TID = F.wave * 64 + LANE; (void)TID;

DI float* xrow(const Ctx& F, int m) { return m < T_LAT ? F.out + (size_t)m * DM : (float*)(F.ws + WS_XCTX) + (size_t)(m - T_LAT) * DM; }
DI const float* xin(const Ctx& F, int m) { return m < T_LAT ? F.in[I_X] + (size_t)m * DM : F.in[I_CTX] + (size_t)(m - T_LAT) * DM; }

DI void transpose_item(const float* W, int K, int N, bf16_t* WT, int k0, int n0, int drow0, LAS float* scr, int lane) {
#pragma unroll 8
    for (int i = 0; i < 32; ++i) { const int kk = 2 * i + (lane >> 5); scr[kk * 33 + (lane & 31)] = __builtin_nontemporal_load(W + (size_t)(k0 + kk) * N + n0 + (lane & 31)); }
    asm volatile("s_waitcnt lgkmcnt(0)" ::: "memory");
    const int c = lane & 7;
#pragma unroll
    for (int j = 0; j < 4; ++j) { const int n = (lane >> 3) + 8 * j; const LAS float* s = scr + (8 * c) * 33 + n;
        u32x4 o; o.x = cvt_pk_bf16(s[0 * 33], s[1 * 33]); o.y = cvt_pk_bf16(s[2 * 33], s[3 * 33]); o.z = cvt_pk_bf16(s[4 * 33], s[5 * 33]); o.w = cvt_pk_bf16(s[6 * 33], s[7 * 33]);
        *(u32x4*)(WT + (size_t)(drow0 + n) * K + k0 + 8 * c) = o; }
    asm volatile("s_waitcnt lgkmcnt(0)" ::: "memory");
}
DI void wconv_layer(const Ctx& F, int l) {
    PHASE_IDS
    LAS float* scr = (LAS float*)(F.lds + F.wave * 8448);
    const int i2 = l >> 1; const bool odd = l & 1;
    const float* Win = odd ? F.in[I_GWIN] + (size_t)i2 * DM * GDN_WREAL : F.in[I_AWIN] + (size_t)i2 * DM * ATT_W;
    const float* Wout = odd ? F.in[I_GWOUT] + (size_t)i2 * DM * DM : F.in[I_AWOUT] + (size_t)i2 * DM * DM;
    const float* Wgu = F.in[I_FGU] + (size_t)l * DM * 2 * FFH; const float* Wdn = F.in[I_FDN] + (size_t)l * FFH * DM;
    bf16_t* win_t = (bf16_t*)(F.ws + WS_WIN); bf16_t* wout_t = (bf16_t*)(F.ws + WS_WOUT); bf16_t* wgu_t = (bf16_t*)(F.ws + WS_WGU); bf16_t* wdn_t = (bf16_t*)(F.ws + WS_WDN);
    const int Nin = odd ? GDN_WREAL : ATT_W;
    const int n_in = 16 * (Nin / 32), n_out = 16 * 32, n_gu = 16 * (2 * FFH / 32), n_dn = (FFH / 64) * 32, n_zero = odd ? (GDN_W - GDN_WREAL) : 0;
    const int total = n_in + n_out + n_gu + n_dn + n_zero;
    for (int it = F.gw; it < total; it += F.ngw) {
        int r = it;
        if (r < n_in) { const int nb = Nin / 32, kb = r / nb, nn = r % nb; transpose_item(Win, DM, Nin, win_t, 64 * kb, 32 * nn, 32 * nn, scr, LANE); continue; } r -= n_in;
        if (r < n_out) { const int kb = r / 32, nn = r % 32; transpose_item(Wout, DM, DM, wout_t, 64 * kb, 32 * nn, 32 * nn, scr, LANE); continue; } r -= n_out;
        if (r < n_gu) { const int nb = 2 * FFH / 32, kb = r / nb, nn = r % nb; const int n0 = 32 * nn, half = n0 / FFH, jj = n0 % FFH; const int drow = (jj / 128) * 256 + half * 128 + (jj % 128);
            transpose_item(Wgu, DM, 2 * FFH, wgu_t, 64 * kb, n0, drow, scr, LANE); continue; } r -= n_gu;
        if (r < n_dn) { const int kb = r / 32, nn = r % 32; transpose_item(Wdn, FFH, DM, wdn_t, 64 * kb, 32 * nn, 32 * nn, scr, LANE); continue; } r -= n_dn;
        { u32x4 z = {0u, 0u, 0u, 0u}; u32x4* p = (u32x4*)(win_t + (size_t)(GDN_WREAL + r) * DM); p[LANE] = z; p[LANE + 64] = z; }
    }
}

DI void modvec_phase(const Ctx& F) {
    PHASE_IDS
    LAS float* sc = (LAS float*)F.lds;
    float* MOD = (float*)(F.ws + WS_MOD);
    for (int it = blockIdx.x; it < 4 * 96; it += F.G) {
        for (int idx = TID; idx < 33 * 1024; idx += NTHREADS) { const int bb = idx >> 10, k = idx & 1023; const float v = bb < 32 ? F.in[I_C][bb * 1024 + k] : F.in[I_CCTX][k]; sc[idx] = silu_f(v); }
        __syncthreads();
        const int l = it / 96, col = (it % 96) * 64 + LANE, k0 = F.wave * 128;
        const float* w = F.in[I_ADAW] + (size_t)l * DM * 6144 + col;
        float acc[33];
#pragma unroll
        for (int i = 0; i < 33; ++i) acc[i] = 0.f;
        for (int k = k0; k < k0 + 128; k += 16) {
            float wv[16];
#pragma unroll
            for (int j = 0; j < 16; ++j) wv[j] = __builtin_nontemporal_load(w + (size_t)(k + j) * 6144);
            int zd = 0;
#pragma unroll
            for (int j4 = 0; j4 < 4; ++j4) {
                const LAS unsigned char* scb = (const LAS unsigned char*)(sc + k + 4 * j4) + zd;
#pragma unroll
                for (int i = 0; i < 33; ++i) { const f32x4 s = *(const LAS f32x4*)(scb + i * 4096); acc[i] += (s[0] * wv[4 * j4] + s[1] * wv[4 * j4 + 1]) + (s[2] * wv[4 * j4 + 2] + s[3] * wv[4 * j4 + 3]); }
                asm volatile("v_and_b32 %0, 0, %1" : "=v"(zd) : "v"(acc[0]), "v"(acc[8]), "v"(acc[16]), "v"(acc[24]), "v"(acc[32]));
            }
        }
        __syncthreads();
#pragma unroll
        for (int i = 0; i < 33; ++i) sc[(F.wave * 33 + i) * 64 + LANE] = acc[i];
        __syncthreads();
        const float* bs = F.in[I_ADAB] + l * 6144 + (it % 96) * 64;
        for (int o = TID; o < 33 * 64; o += NTHREADS) { const int bb = o >> 6, c = o & 63; float sum = bs[c];
#pragma unroll
            for (int wv_ = 0; wv_ < 8; ++wv_) sum += sc[(wv_ * 33 + bb) * 64 + c];
            MOD[(size_t)(l * 33 + bb) * 6144 + (it % 96) * 64 + c] = sum; }
        __syncthreads();
    }
}

DI void rowwise_phase(const Ctx& F, int stage, int l, int Mrows) {
    PHASE_IDS
    const float* MOD = (const float*)(F.ws + WS_MOD); const float* NG = F.in[I_NORMG];
    bf16_t* H = (bf16_t*)(F.ws + WS_H); const bf16_t* Y = (const bf16_t*)(F.ws + WS_Y);
    const bool needh = !(stage == 2 && l == 3), xfromin = (stage == 0) || (stage == 1 && l == 0);
    const int lh = (stage == 2) ? l + 1 : l;
    const int rpw = (Mrows + F.ngw - 1) / F.ngw, mb = F.gw * rpw, me = (mb + rpw < Mrows) ? mb + rpw : Mrows;
    if (mb >= me) return;
    f32x4 ga[4], gb[4], gt[4], sh[4], sc[4];
#pragma unroll
    for (int j = 0; j < 4; ++j) { ga[j] = (f32x4){0.f, 0.f, 0.f, 0.f}; gb[j] = ga[j]; gt[j] = ga[j]; sh[j] = ga[j]; sc[j] = ga[j]; }
    if (stage != 0) { const float* gap = NG + (size_t)(l * 4 + (stage == 1 ? 1 : 3)) * DM;
#pragma unroll
        for (int j = 0; j < 4; ++j) ga[j] = ((const f32x4*)gap)[LANE + 64 * j]; }
    if (needh) { const float* gbp = NG + (size_t)(lh * 4 + (stage == 1 ? 2 : 0)) * DM;
#pragma unroll
        for (int j = 0; j < 4; ++j) gb[j] = ((const f32x4*)gbp)[LANE + 64 * j]; }
    int cur_bb = -1;
    bf16_t* XL = (bf16_t*)((unsigned char*)F.out + 128 * MiB); float* XF = (float*)(F.ws + WS_BIG + 352 * MiB); float* XC = (float*)(F.ws + WS_XCTX);
    f32x4 xn[2][4]; u32x2 yn[2][4], xbn[2][4];
#define RW_SRC16(m_) (!xfromin && (m_) < T_LAT && !(l == 3 && stage == 2))
#define RW_FETCH(m_, q_) do { if (RW_SRC16(m_)) { const u32x2* xb_ = (const u32x2*)(XL + (size_t)(m_) * DM) + LANE; _Pragma("unroll") for (int j = 0; j < 4; ++j) xbn[q_][j] = __builtin_nontemporal_load(xb_ + 64 * j); } \
        else { const float* xr_ = xfromin ? xin(F, (m_)) : ((m_) >= T_LAT ? XC + (size_t)((m_) - T_LAT) * DM : XF + (size_t)(m_) * DM); const f32x4* xp_ = (const f32x4*)xr_ + LANE; \
            _Pragma("unroll") for (int j = 0; j < 4; ++j) xn[q_][j] = __builtin_nontemporal_load(xp_ + 64 * j); } \
        if (stage != 0) { const u32x2* yp_ = (const u32x2*)(Y + (size_t)(m_) * DM) + LANE; _Pragma("unroll") for (int j = 0; j < 4; ++j) yn[q_][j] = __builtin_nontemporal_load(yp_ + 64 * j); } } while (0)
#pragma unroll
    for (int j = 0; j < 4; ++j) { yn[0][j] = (u32x2){0u, 0u}; xbn[0][j] = (u32x2){0u, 0u}; xn[0][j] = (f32x4){0.f, 0.f, 0.f, 0.f}; yn[1][j] = yn[0][j]; xbn[1][j] = xbn[0][j]; xn[1][j] = xn[0][j]; }
    RW_FETCH(mb, 0);
    if (mb + 1 < me) RW_FETCH(mb + 1, 1);
    for (int m0 = mb; m0 < me; m0 += 2) {
#pragma unroll
      for (int q = 0; q < 2; ++q) {
        const int m = m0 + q;
        if (m >= me) break;
        f32x4 x[4]; u32x2 yw[4];
#pragma unroll
        for (int j = 0; j < 4; ++j) { x[j] = RW_SRC16(m) ? (f32x4){bflo(xbn[q][j].x), bfhi(xbn[q][j].x), bflo(xbn[q][j].y), bfhi(xbn[q][j].y)} : xn[q][j]; yw[j] = yn[q][j]; }
        if (m + 2 < me) RW_FETCH(m + 2, q);
        const int bb = m < T_LAT ? (m >> 11) : 32;
        if (bb != cur_bb) { cur_bb = bb;
            if (stage != 0) { const float* md = MOD + (size_t)(l * 33 + bb) * 6144 + (stage == 1 ? 2 * 1024 : 5 * 1024);
#pragma unroll
                for (int j = 0; j < 4; ++j) gt[j] = ((const f32x4*)md)[LANE + 64 * j]; }
            if (needh) { const float* md = MOD + (size_t)(lh * 33 + bb) * 6144 + (stage == 1 ? 3 * 1024 : 0);
#pragma unroll
                for (int j = 0; j < 4; ++j) { sh[j] = ((const f32x4*)md)[LANE + 64 * j]; sc[j] = ((const f32x4*)(md + 1024))[LANE + 64 * j]; } }
        }
        if (stage != 0) {
            f32x4 y[4]; float ss = 0.f;
#pragma unroll
            for (int j = 0; j < 4; ++j) { y[j] = (f32x4){bflo(yw[j].x), bfhi(yw[j].x), bflo(yw[j].y), bfhi(yw[j].y)}; ss += (y[j][0] * y[j][0] + y[j][1] * y[j][1]) + (y[j][2] * y[j][2] + y[j][3] * y[j][3]); }
            const float ry = rsqrtf(wave_sum(ss) * (1.f / DM) + RMS_EPS);
#pragma unroll
            for (int j = 0; j < 4; ++j) x[j] = x[j] + gt[j] * (y[j] * ry * ga[j]);
            if (m < T_LAT && l != 3) { u32x2* xo = (u32x2*)(XL + (size_t)m * DM) + LANE;
#pragma unroll
                for (int j = 0; j < 4; ++j) { u32x2 w; w.x = cvt_pk_bf16(x[j][0], x[j][1]); w.y = cvt_pk_bf16(x[j][2], x[j][3]); __builtin_nontemporal_store(w, xo + 64 * j); } }
            else { float* xr = (m >= T_LAT) ? XC + (size_t)(m - T_LAT) * DM : (stage == 1 ? XF + (size_t)m * DM : F.out + (size_t)m * DM); f32x4* xo = (f32x4*)xr + LANE;
#pragma unroll
                for (int j = 0; j < 4; ++j) xo[64 * j] = x[j]; }
        }
        if (!needh) continue;
        float s2 = 0.f;
#pragma unroll
        for (int j = 0; j < 4; ++j) s2 += (x[j][0] * x[j][0] + x[j][1] * x[j][1]) + (x[j][2] * x[j][2] + x[j][3] * x[j][3]);
        const float rx = rsqrtf(wave_sum(s2) * (1.f / DM) + RMS_EPS);
        u32x2* hp = (u32x2*)(H + (size_t)m * DM) + LANE;
#pragma unroll
        for (int j = 0; j < 4; ++j) { const f32x4 hv = (x[j] * rx * gb[j]) * (sc[j] + 1.0f) + sh[j]; u32x2 w; w.x = cvt_pk_bf16(hv[0], hv[1]); w.y = cvt_pk_bf16(hv[2], hv[3]); hp[64 * j] = w; }
      }
    }
#undef RW_FETCH
#undef RW_SRC16
}
constexpr float QSCALE = 0.125f * 1.4426950408889634f;
DI void attn_prep_phase(const Ctx& F, int i2) {
    PHASE_IDS
    bf16_t* P = (bf16_t*)(F.ws + WS_BIG);
    const int sub = LANE & 15, hsel = LANE >> 4;
    const f32x4 qg0 = *(const f32x4*)(F.in[I_QKG] + (i2 * 2 + 0) * 64 + 4 * sub), qg1 = *(const f32x4*)(F.in[I_QKG] + (i2 * 2 + 1) * 64 + 4 * sub);
    float inv_freq[4];
#pragma unroll
    for (int e = 0; e < 4; ++e) inv_freq[e] = exp2f(-(float)(2 * (4 * (sub & 3) + e)) * (1.0f / 32.0f) * 13.287712379549449f);
    const float sgn = (sub & 4) ? 1.0f : -1.0f;
    const int rpw = (T_ALL + F.ngw - 1) / F.ngw, mb = F.gw * rpw, me = (mb + rpw < T_ALL) ? mb + rpw : T_ALL;
    u32x2 wn[7];
#define AP_FETCH(m_) do { const bf16_t* row_ = P + (size_t)(m_) * ATT_W + hsel * 64 + 4 * sub; \
        _Pragma("unroll") for (int g = 0; g < 7; ++g) { const int c0 = (g < 4) ? 256 * g : 1536 + 256 * (g - 4); wn[g] = (u32x2){0u, 0u}; if (g == 6 && hsel < 2) wn[g] = __builtin_nontemporal_load((const u32x2*)(row_ + c0)); } } while (0)
    if (mb < me) AP_FETCH(mb);
    for (int m = mb; m < me; ++m) {
        bf16_t* row = P + (size_t)m * ATT_W + hsel * 64 + 4 * sub;
        float cs[4] = {1.f, 1.f, 1.f, 1.f}, sn[4] = {0.f, 0.f, 0.f, 0.f};
        if (m < T_LAT) { const int t = m & (SEQ - 1); const float pos = (float)((sub < 8) ? (t >> 6) : (t & 63));
#pragma unroll
            for (int e = 0; e < 4; ++e) sincosf(pos * inv_freq[e], &sn[e], &cs[e]); }
        u32x2 w[7];
#pragma unroll
        for (int g = 0; g < 7; ++g) w[g] = wn[g];
        if (m + 1 < me) AP_FETCH(m + 1);
#pragma unroll
        for (int g = 0; g < 7; ++g) {
            if (g != 6) continue;
            float v[4] = {bflo(w[g].x), bfhi(w[g].x), bflo(w[g].y), bfhi(w[g].y)};
            if (g >= 4) { float ss = (v[0] * v[0] + v[1] * v[1]) + (v[2] * v[2] + v[3] * v[3]); ss += shx<1>(ss); ss += shx<2>(ss); ss += shx<4>(ss); ss += shx<8>(ss);
                const float rs = rsqrtf(ss * (1.0f / 64.0f) + RMS_EPS); const f32x4 gg = (g < 6) ? qg0 : qg1;
#pragma unroll
                for (int e = 0; e < 4; ++e) v[e] = v[e] * rs * gg[e]; }
            const float scl = (g < 2 || g == 4 || g == 5) ? QSCALE : 1.0f;
            float o[4];
#pragma unroll
            for (int e = 0; e < 4; ++e) { const float pr = shx<4>(v[e]); o[e] = (v[e] * cs[e] + sgn * pr * sn[e]) * scl; }
            const int c0 = (g < 4) ? 256 * g : 1536 + 256 * (g - 4);
            u32x2 ow; ow.x = cvt_pk_bf16(o[0], o[1]); ow.y = cvt_pk_bf16(o[2], o[3]);
            if (g < 6 || hsel < 2) *(u32x2*)(row + c0) = ow;
        }
    }
}

constexpr int AK_PITCH = 144, AK_BYTES = 64 * AK_PITCH;
template <int DVT> struct AttnGeo { static constexpr int VP = (DVT == 4) ? 320 : 192, VBYTES = 64 * VP, VOFF = 4 * AK_BYTES; };
template <int DVT>
DI void attn_pass(f32x16 (&acc)[DVT], float& lsum, const Ctx& F, const bf16_t* P, int b, bool ctxq, int qrow, int qcol, int kcol, int vcol, const float* qgam) {
    PHASE_IDS
    typedef AttnGeo<DVT> GEO;
    const int lane = LANE, tid = TID, l31 = lane & 31, h = lane >> 5;
    LAS unsigned char* lds = F.lds;
    const int nt = ctxq ? 4 : 36;
    bf16x8 qf[4];
    {
        float q[4][8];
#pragma unroll
        for (int ks = 0; ks < 4; ++ks) { const u32x4 w = __builtin_nontemporal_load((const u32x4*)(P + (size_t)qrow * ATT_W + qcol + ks * 16 + h * 8));
            q[ks][0] = bflo(w.x); q[ks][1] = bfhi(w.x); q[ks][2] = bflo(w.y); q[ks][3] = bfhi(w.y); q[ks][4] = bflo(w.z); q[ks][5] = bfhi(w.z); q[ks][6] = bflo(w.w); q[ks][7] = bfhi(w.w); }
        if (qgam) {
            float ss = 0.f;
#pragma unroll
            for (int ks = 0; ks < 4; ++ks)
#pragma unroll
                for (int j = 0; j < 8; ++j) ss += q[ks][j] * q[ks][j];
            ss = swp_sum(ss);
            const float rs = rsqrtf(ss * (1.0f / 64.0f) + RMS_EPS);
#pragma unroll
            for (int ks = 0; ks < 4; ++ks) { const f32x4 g0 = *(const f32x4*)(qgam + ks * 16 + h * 8), g1 = *(const f32x4*)(qgam + ks * 16 + h * 8 + 4);
#pragma unroll
                for (int j = 0; j < 4; ++j) { q[ks][j] *= rs * g0[j]; q[ks][4 + j] *= rs * g1[j]; } }
        }
        if (!ctxq) {
            const int tq = qrow & (SEQ - 1); const float pr = (float)(tq >> 6), pc = (float)(tq & 63);
#pragma unroll
            for (int j = 0; j < 8; ++j) {
                const float fr = exp2f(-(float)(2 * (8 * h + j)) * (1.0f / 32.0f) * 13.287712379549449f);
                const float sr = __sinf(pr * fr), cr = __cosf(pr * fr), sc_ = __sinf(pc * fr), cc = __cosf(pc * fr);
                const float a0 = q[0][j], a1 = q[1][j], b0 = q[2][j], b1 = q[3][j];
                q[0][j] = a0 * cr - a1 * sr; q[1][j] = a1 * cr + a0 * sr; q[2][j] = b0 * cc - b1 * sc_; q[3][j] = b1 * cc + b0 * sc_;
            }
        }
#pragma unroll
        for (int ks = 0; ks < 4; ++ks) { u32x4 w; w.x = cvt_pk_bf16(q[ks][0] * QSCALE, q[ks][1] * QSCALE); w.y = cvt_pk_bf16(q[ks][2] * QSCALE, q[ks][3] * QSCALE); w.z = cvt_pk_bf16(q[ks][4] * QSCALE, q[ks][5] * QSCALE); w.w = cvt_pk_bf16(q[ks][6] * QSCALE, q[ks][7] * QSCALE);
            qf[ks] = __builtin_bit_cast(bf16x8, w); }
    }
#pragma unroll
    for (int t = 0; t < DVT; ++t)
#pragma unroll
        for (int r = 0; r < 16; ++r) acc[t][r] = 0.f;
    float mrun = 0.f; lsum = 0.f;
    float nref = 0.f;
    const int krow_s = tid >> 3, kch = tid & 7;
    u32x4 kregA, vregA[DVT / 2];
#define A_ROWBASE(t) ((t) < 4 ? (T_LAT + b * CTXL + 64 * (t)) : (b * SEQ + 64 * ((t) - 4)))
#define A_GLOAD(t, kreg, vreg) do { const int rb_ = A_ROWBASE(t); kreg = *(const u32x4*)(P + (size_t)(rb_ + krow_s) * ATT_W + kcol + kch * 8); \
        if (DVT == 4) { _Pragma("unroll") for (int i_ = 0; i_ < DVT / 2; ++i_) { const int idx_ = tid + 512 * i_; vreg[i_] = *(const u32x4*)(P + (size_t)(rb_ + (idx_ >> 4)) * ATT_W + vcol + (idx_ & 15) * 8); } } \
        else { vreg[0] = *(const u32x4*)(P + (size_t)(rb_ + krow_s) * ATT_W + vcol + kch * 8); } } while (0)
#define A_LSTORE(buf, kreg, vreg) do { *(LAS u32x4*)(lds + (buf) * AK_BYTES + krow_s * AK_PITCH + kch * 16) = kreg;   \
        if (DVT == 4) { _Pragma("unroll") for (int i_ = 0; i_ < DVT / 2; ++i_) { const int idx_ = tid + 512 * i_; *(LAS u32x4*)(lds + GEO::VOFF + (buf) * GEO::VBYTES + (idx_ >> 4) * GEO::VP + (idx_ & 15) * 16) = vreg[i_]; } } \
        else { *(LAS u32x4*)(lds + GEO::VOFF + (buf) * GEO::VBYTES + krow_s * GEO::VP + kch * 16) = vreg[0]; } } while (0)
    const int q4 = (lane & 15) >> 2, p4 = lane & 3, blk = (lane >> 4) & 1;
#define A_TILE(t, cur) do { \
        f32x16 s0, s1; _Pragma("unroll") for (int r = 0; r < 16; ++r) { s0[r] = nref; s1[r] = nref; } \
        const LAS unsigned char* kb = lds + (cur) * AK_BYTES + l31 * AK_PITCH + h * 16; \
        _Pragma("unroll") for (int ks = 0; ks < 4; ++ks) { \
            const bf16x8 a0 = *(const LAS bf16x8*)(kb + ks * 32), a1 = *(const LAS bf16x8*)(kb + 32 * AK_PITCH + ks * 32); \
            s0 = MFMA32(a0, qf[ks], s0); s1 = MFMA32(a1, qf[ks], s1); } \
        float mx = fmaxf(fmaxf(s0[0], s0[1]), s1[0]); \
        _Pragma("unroll") for (int r = 2; r < 16; r += 2) mx = fmaxf(fmaxf(mx, s0[r]), s0[r + 1]); \
        _Pragma("unroll") for (int r = 1; r < 15; r += 2) mx = fmaxf(fmaxf(mx, s1[r]), s1[r + 1]); \
        mx = fmaxf(mx, s1[15]); \
        mx = swp_max(mx); \
        if ((t) == 0 || __builtin_amdgcn_ballot_w64(mx > 6.0f) != 0ull) { \
            const float dl = ((t) == 0) ? mx : fmaxf(mx, 0.f), alpha = ((t) == 0) ? 1.0f : __builtin_amdgcn_exp2f(-dl); \
            mrun += dl; lsum *= alpha; \
            _Pragma("unroll") for (int r = 0; r < 16; ++r) { s0[r] -= dl; s1[r] -= dl; } nref = -mrun; \
            _Pragma("unroll") for (int tt = 0; tt < DVT; ++tt) _Pragma("unroll") for (int r = 0; r < 16; ++r) acc[tt][r] *= alpha; } \
        float psum = 0.f; \
        _Pragma("unroll") for (int r = 0; r < 16; ++r) { s0[r] = __builtin_amdgcn_exp2f(s0[r]); s1[r] = __builtin_amdgcn_exp2f(s1[r]); psum += s0[r] + s1[r]; } \
        lsum += psum; \
        bf16x8 pf[4]; pf[0] = pack_step<0>(s0); pf[1] = pack_step<1>(s0); pf[2] = pack_step<0>(s1); pf[3] = pack_step<1>(s1); \
        const LAS unsigned char* vb = lds + GEO::VOFF + (cur) * GEO::VBYTES + (4 * h + q4) * GEO::VP + (16 * blk + 4 * p4) * 2; \
        _Pragma("unroll") for (int kk = 0; kk < 4; ++kk) { const int kbase = 32 * (kk >> 1) + 16 * (kk & 1); \
            _Pragma("unroll") for (int tt = 0; tt < DVT; ++tt) { \
                const s16x4 lo = tr_read(vb + kbase * GEO::VP + tt * 64), hi = tr_read(vb + (kbase + 8) * GEO::VP + tt * 64); \
                acc[tt] = MFMA32(cat8(lo, hi), pf[kk], acc[tt]); } } } while (0)
    A_GLOAD(0, kregA, vregA); A_LSTORE(0, kregA, vregA); A_GLOAD(1, kregA, vregA); A_LSTORE(1, kregA, vregA);
    __syncthreads();
    const int ns = nt >> 1;
    for (int sg = 0; sg < ns; ++sg) {
        const int sb = (sg & 1) * 2;
        if (sg + 1 < ns) A_GLOAD(2 * sg + 2, kregA, vregA);
        A_TILE(2 * sg, sb);
        if (sg + 1 < ns) { A_LSTORE((sb ^ 2), kregA, vregA); A_GLOAD(2 * sg + 3, kregA, vregA); }
        A_TILE(2 * sg + 1, sb + 1);
        if (sg + 1 < ns) A_LSTORE((sb ^ 2) + 1, kregA, vregA);
        __syncthreads();
    }
#undef A_TILE
    lsum = swp_sum(lsum);
#undef A_ROWBASE
#undef A_GLOAD
#undef A_LSTORE
}

DI void attn_phase(const Ctx& F, int l) {
    PHASE_IDS
    const int i2 = l >> 1; const bf16_t* P = (const bf16_t*)(F.ws + WS_BIG); bf16_t* O = (bf16_t*)(F.ws + WS_H);
    const int lane = LANE, l31 = lane & 31, h = lane >> 5;
    const float lam_init = 0.8f - 0.6f * expf(-0.3f * (float)l);
    float lam;
    { const float* lv = F.in[I_DLAM] + i2 * 256; const float a = wave_sum(lv[lane] * lv[64 + lane]), bsum = wave_sum(lv[128 + lane] * lv[192 + lane]); lam = expf(a) - expf(bsum) + lam_init; }
    constexpr int NU = 1024 + 2048 + 128 + 256;
    const int vcu = (F.G % 8 == 0) ? ((int)blockIdx.x % 8) * (F.G / 8) + (int)blockIdx.x / 8 : (int)blockIdx.x;
    for (int u = vcu; u < NU; u += F.G) {
        int b, hd, qb; bool diff, ctxq;
        if (u < 1024) { diff = true; ctxq = false; b = u >> 5; hd = (u >> 3) & 3; qb = u & 7; }
        else if (u < 3072) { const int v = u - 1024; diff = false; ctxq = false; b = v >> 6; hd = (v >> 3) & 7; qb = v & 7; }
        else if (u < 3200) { const int v = u - 3072; diff = true; ctxq = true; b = v >> 2; hd = v & 3; qb = 0; }
        else { const int v = u - 3200; diff = false; ctxq = true; b = v >> 3; hd = v & 7; qb = 0; }
        const int qrow = (ctxq ? T_LAT + b * CTXL : b * SEQ + qb * 256) + F.wave * 32 + l31;
        if (diff) {
            f32x16 a1[4], a2[4]; float l1, l2;
            attn_pass<4>(a1, l1, F, P, b, ctxq, qrow, hd * 128, 512 + hd * 128, 1024 + hd * 128, nullptr);
            attn_pass<4>(a2, l2, F, P, b, ctxq, qrow, hd * 128 + 64, 512 + hd * 128 + 64, 1024 + hd * 128, nullptr);
            const float i1 = 1.0f / l1, i2s = lam / l2; float ss = 0.f;
#pragma unroll
            for (int t = 0; t < 4; ++t)
#pragma unroll
                for (int r = 0; r < 16; ++r) { const float o = a1[t][r] * i1 - a2[t][r] * i2s; a1[t][r] = o; ss += o * o; }
            ss = swp_sum(ss);
            const float rs = rsqrtf(ss * (1.0f / 128.0f) + RMS_EPS) * (1.0f - lam_init);
            const float* sg = F.in[I_SUBLN] + i2 * 128;
            bf16_t* orow = O + (size_t)qrow * DM + hd * 128;
#pragma unroll
            for (int t = 0; t < 4; ++t)
#pragma unroll
                for (int g = 0; g < 4; ++g) { const int dv = t * 32 + 8 * g + 4 * h; const f32x4 gg = *(const f32x4*)(sg + dv);
                    u32x2 w; w.x = cvt_pk_bf16(a1[t][4 * g] * rs * gg[0], a1[t][4 * g + 1] * rs * gg[1]); w.y = cvt_pk_bf16(a1[t][4 * g + 2] * rs * gg[2], a1[t][4 * g + 3] * rs * gg[3]);
                    *(u32x2*)(orow + dv) = w; }
        } else {
            f32x16 a1[2]; float l1;
            attn_pass<2>(a1, l1, F, P, b, ctxq, qrow, 1536 + hd * 64, 2048 + (hd >> 2) * 64, 2176 + (hd >> 2) * 64, F.in[I_QKG] + (i2 * 2 + 0) * 64);
            const float i1 = 1.0f / l1;
            bf16_t* orow = O + (size_t)qrow * DM + 512 + hd * 64;
#pragma unroll
            for (int t = 0; t < 2; ++t)
#pragma unroll
                for (int g = 0; g < 4; ++g) { const int dv = t * 32 + 8 * g + 4 * h;
                    u32x2 w; w.x = cvt_pk_bf16(a1[t][4 * g] * i1, a1[t][4 * g + 1] * i1); w.y = cvt_pk_bf16(a1[t][4 * g + 2] * i1, a1[t][4 * g + 3] * i1);
                    *(u32x2*)(orow + dv) = w; }
        }
    }
}
constexpr int GP = 272;
constexpr int GU_Q = 0, GU_K = 64 * GP, GU_V = 2 * 64 * GP, GU_M = 3 * 64 * GP, GU_ATT = 4 * 64 * GP, GU_SC = GU_ATT + 6144, GU_M10 = GU_SC + 1024, GU_BYTES = 80896;
DI f32x16 tile_nt(const LAS unsigned char* A, const LAS unsigned char* B, int l31, int h) {
    f32x16 c;
#pragma unroll
    for (int r = 0; r < 16; ++r) c[r] = 0.f;
    const LAS unsigned char* ap = A + l31 * GP + h * 16; const LAS unsigned char* bp = B + l31 * GP + h * 16;
#pragma unroll
    for (int ks = 0; ks < 8; ++ks) c = MFMA32(*(const LAS bf16x8*)(ap + ks * 32), *(const LAS bf16x8*)(bp + ks * 32), c);
    return c;
}
DI float softplus_f(float x) { const float e = __expf(x); const float sm = e * (1.0f - e * (0.5f - e * 0.33333334f)); return x > 20.f ? x : (e < 0.01f ? sm : __logf(1.0f + e)); }

DI void gdn_scan_phase(const Ctx& F, int l) {
    const int i2 = l >> 1;
    const bf16_t* P = (const bf16_t*)(F.ws + WS_BIG);
    const float* convw = F.in[I_GCONV] + (size_t)i2 * 4 * 3072;
    const int w4 = F.wave & 3, ub = F.wave >> 2;
    const int e0 = 32 * w4;
    for (int u0 = 2 * blockIdx.x; u0 < 512; u0 += 2 * F.G) {
        const int u = u0 + ub, b = u >> 4, hd = (u >> 1) & 7, dir = u & 1;
        bf16_t* Od = (bf16_t*)(F.ws + (dir ? WS_Y : WS_H));
        const float nalog = __uint_as_float(__builtin_amdgcn_readfirstlane(__float_as_uint(-__expf(F.in[I_GALOG][i2 * 16 + dir * 8 + hd])))), dtb = __uint_as_float(__builtin_amdgcn_readfirstlane(__float_as_uint(F.in[I_GDT][i2 * 16 + dir * 8 + hd])));
        f32x16 S[4];
#pragma unroll
        for (int t = 0; t < 4; ++t)
#pragma unroll
            for (int r = 0; r < 16; ++r) S[t][r] = 0.f;
        for (int step = 0; step < 36; ++step) {
            const bool isctx = step < 4; const int cidx = dir ? (isctx ? 3 - step : 35 - step) : (isctx ? step : step - 4);
            const int seq0 = isctx ? T_LAT + b * CTXL : b * SEQ, L = isctx ? CTXL : SEQ, t0 = 64 * cidx;
            const int lane = get_lane(); const int ut = (F.wave & 3) * 64 + lane;
            const int l31 = lane & 31, h = lane >> 5, q4 = (lane & 15) >> 2, p4 = lane & 3, blk = (lane >> 4) & 1;
            int zs; asm volatile("s_mov_b32 %0, 0" : "=s"(zs));
            LAS unsigned char* U = F.lds + ub * GU_BYTES + zs;
            LAS float* SC = (LAS float*)(U + GU_SC);
            const LAS float* SCh = SC + 4 * h + zs;
#ifndef GDN_NOSTAGE
            unsigned pf0 = 0u, pf1 = 0u;
            {
                const int seg = ut >> 4, cg8 = ut & 15;
                const float* cwl = convw + zs;
                const bf16_t* pbase = P + (size_t)seq0 * GDN_W + hd * 128 + cg8 * 8;
                u32x4 rawA[7], rawB[7];
#define GS_LOAD(raw, MAT) do { _Pragma("unroll") for (int rr = 0; rr < 7; ++rr) { const int ts = t0 + 4 * seg - 2 + rr; u32x4 w_ = {0u, 0u, 0u, 0u}; \
                    if (ts >= 0 && ts < L) w_ = *(const u32x4*)(pbase + (size_t)ts * GDN_W + (MAT) * 1024); raw[rr] = w_; } } while (0)
#define GS_PROC(raw, MAT) do { const int col0 = (MAT) * 1024 + hd * 128 + cg8 * 8; float o[4][8]; \
                    _Pragma("unroll") for (int a = 0; a < 4; ++a) _Pragma("unroll") for (int c = 0; c < 8; ++c) o[a][c] = 0.f; \
                    _Pragma("unroll") for (int j = 0; j < 4; ++j) { const f32x4 wa = *(const f32x4*)(cwl + j * 3072 + col0), wb = *(const f32x4*)(cwl + j * 3072 + col0 + 4); \
                        _Pragma("unroll") for (int a = 0; a < 4; ++a) { const u32x4 w_ = raw[a + j]; \
                            o[a][0] += wa[0] * bflo(w_.x); o[a][1] += wa[1] * bfhi(w_.x); o[a][2] += wa[2] * bflo(w_.y); o[a][3] += wa[3] * bfhi(w_.y); \
                            o[a][4] += wb[0] * bflo(w_.z); o[a][5] += wb[1] * bfhi(w_.z); o[a][6] += wb[2] * bflo(w_.w); o[a][7] += wb[3] * bfhi(w_.w); } } \
                    _Pragma("unroll") for (int a = 0; a < 4; ++a) { float ss = 0.f; \
                        _Pragma("unroll") for (int c = 0; c < 8; ++c) { o[a][c] = silu_f(o[a][c]); ss += o[a][c] * o[a][c]; } \
                        float sc = 1.0f; \
                        if ((MAT) < 2) { ss += shx<1>(ss); ss += shx<2>(ss); ss += shx<4>(ss); ss += shx<8>(ss); sc = rsqrtf(ss + 1e-6f) * ((MAT) == 0 ? 0.08838834764831845f : 1.0f); } \
                        const int tk = 4 * seg + a, row = dir ? 63 - tk : tk; \
                        u32x4 w; w.x = cvt_pk_bf16(o[a][0] * sc, o[a][1] * sc); w.y = cvt_pk_bf16(o[a][2] * sc, o[a][3] * sc); w.z = cvt_pk_bf16(o[a][4] * sc, o[a][5] * sc); w.w = cvt_pk_bf16(o[a][6] * sc, o[a][7] * sc); \
                        *(LAS u32x4*)(U + (MAT) * 64 * GP + row * GP + cg8 * 16) = w; } } while (0)
                bf16_t av_r = 0, bv_r = 0;
                if (w4 == 0) { const int tk = dir ? 63 - lane : lane; const bf16_t* prow = P + (size_t)(seq0 + t0 + tk) * GDN_W + 4096 + dir * 8 + hd; av_r = prow[0]; bv_r = prow[16]; }
                GS_LOAD(rawA, 0); GS_LOAD(rawB, 1);
                GS_PROC(rawA, 0);
                GS_LOAD(rawA, 2);
                GS_PROC(rawB, 1);
                GS_PROC(rawA, 2);
#undef GS_LOAD
#undef GS_PROC
                if (w4 == 0) {
                    const float av = bf2f(av_r), bv = bf2f(bv_r);
                    float g = nalog * softplus_f(av + dtb);
#pragma unroll
                    for (int off = 1; off < 64; off <<= 1) { const float t_ = __int_as_float(__builtin_amdgcn_ds_bpermute((lane - off) << 2, __float_as_int(g))); if (lane >= off) g += t_; }
                    const float glast = __int_as_float(__builtin_amdgcn_readlane(__float_as_int(g), 63));
                    SC[lane] = g; SC[64 + lane] = 1.0f / (1.0f + __expf(-bv)); SC[128 + lane] = __expf(g); SC[192 + lane] = __expf(glast - g);
                }
                if (step + 1 < 36) {
                    const int st1 = step + 1; const bool ic1 = st1 < 4; const int ci1 = dir ? (ic1 ? 3 - st1 : 35 - st1) : (ic1 ? st1 : st1 - 4);
                    const int sq1 = ic1 ? T_LAT + b * CTXL : b * SEQ, L1 = ic1 ? CTXL : SEQ, t1 = 64 * ci1;
                    const int li0 = ut, li1 = ut + 256;
                    { const int row = li0 / 6, part = li0 % 6, ts = t1 - 2 + row; if (ts >= 0 && ts < L1) pf0 = *(const unsigned*)(P + (size_t)(sq1 + ts) * GDN_W + (part >> 1) * 1024 + hd * 128 + (part & 1) * 64); }
                    if (li1 < 402) { const int row = li1 / 6, part = li1 % 6, ts = t1 - 2 + row; if (ts >= 0 && ts < L1) pf1 = *(const unsigned*)(P + (size_t)(sq1 + ts) * GDN_W + (part >> 1) * 1024 + hd * 128 + (part & 1) * 64); }
                }
            }
#endif
            __syncthreads();
#ifndef GDN_NOTILES
            {
                const LAS unsigned char* Qm = U + GU_Q; const LAS unsigned char* Km = U + GU_K;
                if (w4 < 3) {
                    const int jt = (w4 == 2) ? 1 : 0, it = (w4 == 0) ? 0 : 1;
                    f32x16 c = tile_nt(Km + 32 * jt * GP, Qm + 32 * it * GP, l31, h);
                    const int i = 32 * it + l31; const float gi = SC[i]; const int im = i - 4 * h + zs - 32 * jt;
#pragma unroll
                    for (int r = 0; r < 16; ++r) { const int c0 = (r & 3) + 8 * (r >> 2); const float ar = fminf(gi - SCh[32 * jt + c0], 0.f); c[r] = (c0 <= im) ? c[r] * __expf(ar) : 0.f; }
                    *(LAS bf16x8*)(U + GU_ATT + ((w4 * 2 + 0) * 64 + lane) * 16) = pack_step<0>(c);
                    *(LAS bf16x8*)(U + GU_ATT + ((w4 * 2 + 1) * 64 + lane) * 16) = pack_step<1>(c);
                }
                if (w4 == 0) {
                    f32x16 c = tile_nt(Km, Km + 32 * GP, l31, h);
                    const int i = 32 + l31; const float gi = SC[i], bi = SC[64 + i];
#pragma unroll
                    for (int r = 0; r < 16; ++r) { const int c0 = (r & 3) + 8 * (r >> 2); const float ar = fminf(gi - SCh[c0], 0.f); c[r] = bi * c[r] * __expf(ar); }
                    *(LAS bf16x8*)(U + GU_M10 + (0 * 64 + lane) * 16) = pack_step<0>(c);
                    *(LAS bf16x8*)(U + GU_M10 + (1 * 64 + lane) * 16) = pack_step<1>(c);
                }
                if (w4 == 1 || w4 == 3) {
                    const int ti = (w4 == 3) ? 0 : 1, tj = ti;
                    f32x16 c = tile_nt(Km + 32 * ti * GP, Km + 32 * tj * GP, l31, h);
                    const int j = 32 * tj + l31; const float gj = SC[j]; const int jm = j - 4 * h + zs - 32 * ti;
                    LAS unsigned char* mb = U + GU_M + (32 * ti + 4 * h) * GP + j * 4 + zs;
#pragma unroll
                    for (int r = 0; r < 16; ++r) { const int c0 = (r & 3) + 8 * (r >> 2); const float ar = fminf(SCh[32 * ti + c0] - gj, 0.f); const float mv = (c0 > jm) ? SCh[64 + 32 * ti + c0] * c[r] * __expf(ar) : 0.f;
                        *(LAS float*)(mb + c0 * GP) = mv; }
                    { const int i = 32 * ti + l31; const float gi = SC[i], bi = SC[64 + i]; f32x16 cc;
#pragma unroll
                      for (int r = 0; r < 16; ++r) { const int c0 = (r & 3) + 8 * (r >> 2); const float ar = fminf(gi - SCh[32 * ti + c0], 0.f); cc[r] = (r < 8 && l31 >= 16) ? bi * c[r] * __expf(ar) : 0.f; }
                      *(LAS bf16x8*)(U + GU_M10 + ((2 + ti) * 64 + lane) * 16) = pack_step<0>(cc); }
                }
            }
#endif
            __syncthreads();
            __builtin_amdgcn_sched_barrier(0);
            f32x16 R[2];
#pragma unroll
            for (int t = 0; t < 2; ++t)
#pragma unroll
                for (int r = 0; r < 16; ++r) R[t][r] = 0.f;
#define GD_KS(DT, SS) do { const bf16x8 sf = pack_step<SS>(S[DT]); const int dcol = (32 * (DT) + 16 * (SS) + 4 * h) * 2; \
                _Pragma("unroll") for (int it = 0; it < 2; ++it) { const LAS unsigned char* rp = U + (32 * it + l31) * GP + dcol; \
                    const bf16x8 ak = cat8(*(const LAS s16x4*)(rp + GU_K), *(const LAS s16x4*)(rp + GU_K + 16)); \
                    R[it] = MFMA32(ak, sf, R[it]); } } while (0)
            GD_KS(0, 0); GD_KS(0, 1); GD_KS(1, 0); GD_KS(1, 1); GD_KS(2, 0); GD_KS(2, 1); GD_KS(3, 0); GD_KS(3, 1);
#undef GD_KS
            __builtin_amdgcn_sched_barrier(0);
            f32x16 X[2];
#pragma unroll
            for (int t = 0; t < 2; ++t)
#pragma unroll
                for (int r = 0; r < 16; ++r) { const int c0 = 32 * t + (r & 3) + 8 * (r >> 2); const float vv = bf2f(*(const LAS bf16_t*)(U + GU_V + 4 * h * GP + (e0 + l31) * 2 + zs + c0 * GP)); const float eg = SCh[128 + c0];
                    X[t][r] = SCh[64 + c0] * (vv - eg * R[t][r]); }
#ifndef GDN_NOSTAGE
            asm volatile("" :: "v"(pf0), "v"(pf1));
#endif
            asm volatile("" : "+v"(X[0]), "+v"(X[1]));
            __builtin_amdgcn_sched_barrier(0);
#ifndef GDN_NOSOLVE
            {
                const LAS unsigned char* Mh = U + GU_M + 4 * h * GP;
                float xs[2][16];
#pragma unroll
                for (int t_ = 0; t_ < 2; ++t_)
#pragma unroll
                    for (int r_ = 0; r_ < 16; ++r_) xs[t_][r_] = X[t_][r_];
                int zdep = 0;
#pragma unroll
                for (int G = 0; G < 16; ++G) {
                    const int t = G >> 3, rb = 4 * ((G >> 1) & 3), hG = G & 1, i0 = 4 * G;
                    {
                        const bool own = (h == hG);
                        const LAS unsigned char* mp = U + GU_M + i0 * GP + i0 * 4 + zdep;
                        const float m10 = *(const LAS float*)(mp + GP); const f32x2 m2 = *(const LAS f32x2*)(mp + 2 * GP); const f32x4 m3 = *(const LAS f32x4*)(mp + 3 * GP);
                        const float n1 = xs[t][rb + 1] - m10 * xs[t][rb]; xs[t][rb + 1] = own ? n1 : xs[t][rb + 1];
                        const float n2 = xs[t][rb + 2] - (m2[0] * xs[t][rb] + m2[1] * xs[t][rb + 1]); xs[t][rb + 2] = own ? n2 : xs[t][rb + 2];
                        const float n3 = xs[t][rb + 3] - (m3[0] * xs[t][rb] + m3[1] * xs[t][rb + 1] + m3[2] * xs[t][rb + 2]); xs[t][rb + 3] = own ? n3 : xs[t][rb + 3];
                    }
                    __builtin_amdgcn_sched_barrier(0);
                    float v0 = xs[t][rb], v1 = xs[t][rb + 1], v2 = xs[t][rb + 2], v3 = xs[t][rb + 3];
                    const float o0 = swp_other(v0, h), o1 = swp_other(v1, h), o2 = swp_other(v2, h), o3 = swp_other(v3, h);
                    v0 = (h != hG) ? o0 : v0; v1 = (h != hG) ? o1 : v1; v2 = (h != hG) ? o2 : v2; v3 = (h != hG) ? o3 : v3;
                    asm volatile("v_and_b32 %0, 0, %1" : "=v"(zdep) : "v"(v3));
#pragma unroll
                    for (int tt = 0; tt < 2; ++tt)
#pragma unroll
                        for (int rg = 0; rg < 4; ++rg) {
                            const int Gb = 8 * tt + 2 * rg;
                            if (Gb >= G && ((Gb >> 2) == (G >> 2))) {
                                const LAS unsigned char* Mz = Mh + zdep;
                                const bool upd = (Gb > G) || (h == 1);
#pragma unroll
                                for (int a = 0; a < 4; ++a) { const f32x4 mm = *(const LAS f32x4*)(Mz + (32 * tt + 8 * rg + a) * GP + i0 * 4);
                                    const float nv = xs[tt][4 * rg + a] - ((mm[0] * v0 + mm[1] * v1) + (mm[2] * v2 + mm[3] * v3)); xs[tt][4 * rg + a] = upd ? nv : xs[tt][4 * rg + a]; }
                                if (rg == 3) asm volatile("v_and_b32 %0, 0, %1" : "=v"(zdep) : "v"(xs[tt][15]), "v"(xs[tt][14]), "v"(xs[tt][13]), "v"(xs[tt][12]), "v"(xs[tt][11]), "v"(xs[tt][10]), "v"(xs[tt][9]), "v"(xs[tt][8]), "v"(xs[tt][7]), "v"(xs[tt][6]), "v"(xs[tt][5]), "v"(xs[tt][4]), "v"(xs[tt][3]), "v"(xs[tt][2]), "v"(xs[tt][1]), "v"(xs[tt][0]));
                            }
                        }
                    if (G == 3 || G == 11) {
                        const int tq = G >> 3; f32x16 xb, ab;
#pragma unroll
                        for (int r_ = 0; r_ < 16; ++r_) { xb[r_] = xs[tq][r_]; ab[r_] = 0.f; }
                        ab = MFMA32(*(const LAS bf16x8*)(U + GU_M10 + (2 + tq) * 1024 + lane * 16 + zdep), pack_step<0>(xb), ab);
#pragma unroll
                        for (int r_ = 0; r_ < 16; ++r_) xs[tq][r_] -= ab[r_];
                    }
                    if (G == 7) {
                        f32x16 x0, a10;
#pragma unroll
                        for (int r_ = 0; r_ < 16; ++r_) { x0[r_] = xs[0][r_]; a10[r_] = 0.f; }
                        const LAS unsigned char* mf = U + GU_M10 + lane * 16 + zdep;
                        a10 = MFMA32(*(const LAS bf16x8*)(mf), pack_step<0>(x0), a10);
                        a10 = MFMA32(*(const LAS bf16x8*)(mf + 1024), pack_step<1>(x0), a10);
#pragma unroll
                        for (int r_ = 0; r_ < 16; ++r_) xs[1][r_] -= a10[r_];
                    }
                }
#pragma unroll
                for (int t_ = 0; t_ < 2; ++t_)
#pragma unroll
                    for (int r_ = 0; r_ < 16; ++r_) X[t_][r_] = xs[t_][r_];
            }
#endif
            __builtin_amdgcn_sched_barrier(0);
#ifndef GDN_NOPOST
            {
                int zs2; asm volatile("v_and_b32 %0, 0, %1" : "=v"(zs2) : "v"(X[1][15]));
                const LAS float* SCh2 = (const LAS float*)((const LAS unsigned char*)(SC + 4 * h) + zs2);
                const LAS unsigned char* U2 = U + zs2;
                asm volatile("" : "+v"(S[0]), "+v"(S[1]), "+v"(S[2]), "+v"(S[3]));
                f32x16 Oq[2];
#pragma unroll
                for (int t = 0; t < 2; ++t)
#pragma unroll
                    for (int r = 0; r < 16; ++r) Oq[t][r] = 0.f;
#define GD_QS(DT, SS) do { const bf16x8 sf = pack_step<SS>(S[DT]); const int dcol = (32 * (DT) + 16 * (SS) + 4 * h) * 2; \
                _Pragma("unroll") for (int it = 0; it < 2; ++it) { const LAS unsigned char* rp = U2 + (32 * it + l31) * GP + dcol; \
                    const bf16x8 aq = cat8(*(const LAS s16x4*)(rp + GU_Q), *(const LAS s16x4*)(rp + GU_Q + 16)); \
                    Oq[it] = MFMA32(aq, sf, Oq[it]); } } while (0)
                GD_QS(0, 0); GD_QS(0, 1); GD_QS(1, 0); GD_QS(1, 1); GD_QS(2, 0); GD_QS(2, 1); GD_QS(3, 0); GD_QS(3, 1);
#undef GD_QS
#pragma unroll
                for (int t = 0; t < 2; ++t)
#pragma unroll
                    for (int r = 0; r < 16; ++r) Oq[t][r] *= SCh2[128 + 32 * t + (r & 3) + 8 * (r >> 2)];
                const bf16x8 vf0 = pack_step<0>(X[0]), vf1 = pack_step<1>(X[0]), vf2 = pack_step<0>(X[1]), vf3 = pack_step<1>(X[1]);
                const LAS unsigned char* at = U2 + GU_ATT + lane * 16;
                Oq[0] = MFMA32(*(const LAS bf16x8*)(at + 0 * 1024), vf0, Oq[0]); Oq[0] = MFMA32(*(const LAS bf16x8*)(at + 1 * 1024), vf1, Oq[0]);
                Oq[1] = MFMA32(*(const LAS bf16x8*)(at + 2 * 1024), vf0, Oq[1]); Oq[1] = MFMA32(*(const LAS bf16x8*)(at + 3 * 1024), vf1, Oq[1]);
                Oq[1] = MFMA32(*(const LAS bf16x8*)(at + 4 * 1024), vf2, Oq[1]); Oq[1] = MFMA32(*(const LAS bf16x8*)(at + 5 * 1024), vf3, Oq[1]);
                const int sdm = dir ? -DM : DM;
                bf16_t* ob = Od + (size_t)(seq0 + t0 + (dir ? 63 - 4 * h : 4 * h)) * DM + hd * 128 + e0 + l31;
#pragma unroll
                for (int t = 0; t < 2; ++t)
#pragma unroll
                    for (int rg = 0; rg < 4; ++rg) { bf16_t* pg = ob + (32 * t + 8 * rg) * sdm;
#pragma unroll
                        for (int a = 0; a < 4; ++a) __builtin_nontemporal_store(f2bf(Oq[t][4 * rg + a]), pg + a * sdm); }
            }
            __builtin_amdgcn_sched_barrier(0);
            {
                int zs3; asm volatile("v_and_b32 %0, 0, %1" : "=v"(zs3) : "v"(X[0][0]));
                const LAS float* SCh3 = (const LAS float*)((const LAS unsigned char*)(SC + 4 * h) + zs3);
                const float gl = SC[128 + 63];
#pragma unroll
                for (int t = 0; t < 4; ++t)
#pragma unroll
                    for (int r = 0; r < 16; ++r) S[t][r] *= gl;
#pragma unroll
                for (int t = 0; t < 2; ++t)
#pragma unroll
                    for (int r = 0; r < 16; ++r) X[t][r] *= SCh3[192 + 32 * t + (r & 3) + 8 * (r >> 2)];
                const bf16x8 vf[4] = {pack_step<0>(X[0]), pack_step<1>(X[0]), pack_step<0>(X[1]), pack_step<1>(X[1])};
                const LAS unsigned char* kt = U + GU_K + (4 * h + q4) * GP + (16 * blk + 4 * p4) * 2 + zs3;
#pragma unroll
                for (int jk = 0; jk < 4; ++jk) {
                    const int ib = 32 * (jk >> 1) + 16 * (jk & 1);
#pragma unroll
                    for (int dt = 0; dt < 4; ++dt) { const s16x4 lo = tr_read(kt + ib * GP + dt * 64), hi = tr_read(kt + (ib + 8) * GP + dt * 64); S[dt] = MFMA32(cat8(lo, hi), vf[jk], S[dt]); }
                }
            }
#else
            S[0][0] += X[0][0] + X[1][15]; S[1][3] += X[0][7];
#endif
            __syncthreads();
        }
    }
}

DI void gdn_readout_phase(const Ctx& F, int l, int Mrows) {
    PHASE_IDS
    const int i2 = l >> 1; const bf16_t* P = (const bf16_t*)(F.ws + WS_BIG); bf16_t* Of = (bf16_t*)(F.ws + WS_H); const bf16_t* Ob = (const bf16_t*)(F.ws + WS_Y);
    const f32x4 gg = *(const f32x4*)(F.in[I_GNORM] + i2 * 128 + ((4 * LANE) & 127));
    const int rpw = (Mrows + F.ngw - 1) / F.ngw, mb = F.gw * rpw, me = (mb + rpw < Mrows) ? mb + rpw : Mrows;
    if (mb >= me) return;
    u32x2 an[4], bn[4], zn[4];
#define RO_FETCH(m_) do { const u32x2* ofp_ = (const u32x2*)(Of + (size_t)(m_) * DM) + LANE; const u32x2* obp_ = (const u32x2*)(Ob + (size_t)(m_) * DM) + LANE; const u32x2* zp_ = (const u32x2*)(P + (size_t)(m_) * GDN_W + 3072) + LANE; \
        _Pragma("unroll") for (int j = 0; j < 4; ++j) { an[j] = __builtin_nontemporal_load(ofp_ + 64 * j); bn[j] = __builtin_nontemporal_load(obp_ + 64 * j); zn[j] = __builtin_nontemporal_load(zp_ + 64 * j); } } while (0)
    RO_FETCH(mb);
    for (int m = mb; m < me; ++m) {
        u32x2 av[4], bv[4], zv[4];
#pragma unroll
        for (int j = 0; j < 4; ++j) { av[j] = an[j]; bv[j] = bn[j]; zv[j] = zn[j]; }
        if (m + 1 < me) RO_FETCH(m + 1);
        u32x2* ofp = (u32x2*)(Of + (size_t)m * DM) + LANE;
#pragma unroll
        for (int j = 0; j < 4; ++j) {
            const u32x2 a = av[j], bq = bv[j], z = zv[j];
            f32x4 o = (f32x4){bflo(a.x) + bflo(bq.x), bfhi(a.x) + bfhi(bq.x), bflo(a.y) + bflo(bq.y), bfhi(a.y) + bfhi(bq.y)};
            float ss = (o[0] * o[0] + o[1] * o[1]) + (o[2] * o[2] + o[3] * o[3]);
            ss += shx<1>(ss); ss += shx<2>(ss); ss += shx<4>(ss); ss += shx<8>(ss); ss += shx<16>(ss);
            const float rs = rsqrtf(ss * (1.0f / 128.0f) + RMS_EPS);
            const f32x4 zz = (f32x4){bflo(z.x), bfhi(z.x), bflo(z.y), bfhi(z.y)};
            u32x2 w; w.x = cvt_pk_bf16(o[0] * rs * gg[0] * silu_f(zz[0]), o[1] * rs * gg[1] * silu_f(zz[1])); w.y = cvt_pk_bf16(o[2] * rs * gg[2] * silu_f(zz[2]), o[3] * rs * gg[3] * silu_f(zz[3]));
            ofp[64 * j] = w;
        }
    }
#undef RO_FETCH
}
#define XB_TMO      128
#define XB_XCNT(j)  (256  + 64 * (j))
#define XB_XSUB(j)  (1280 + 64 * (j))
#define XB_XGEN(j)  (2304 + 64 * (j))
#define XB_TOP      3328
#define XB_TOPGEN   3392
#define XCD_BAR_WORDS 3456
#define XB_SPIN_CAP (1u << 24)

__device__ __forceinline__ unsigned xb_ld(unsigned* p)              { return __hip_atomic_load(p, __ATOMIC_RELAXED, __HIP_MEMORY_SCOPE_AGENT); }
__device__ __forceinline__ unsigned xb_add(unsigned* p, unsigned v) { return __hip_atomic_fetch_add(p, v, __ATOMIC_RELAXED, __HIP_MEMORY_SCOPE_AGENT); }
__device__ __forceinline__ unsigned xb_xcc_id() { return (unsigned)__builtin_amdgcn_s_getreg((3 << 11) | 20) & 0xFu; }
#define XB_SPIN(cond, bar) do { unsigned _sp = 0; while (cond) { __builtin_amdgcn_s_sleep(1); \
    if ((++_sp & 255u) == 0u) { if (xb_ld(&(bar)[XB_TMO])) break; if (_sp > XB_SPIN_CAP) { atomicAdd(&(bar)[XB_TMO], 1u); break; } } } } while (0)

struct XcdBarrier {
    unsigned* bar; unsigned x;
    volatile LAS unsigned* st;
};

__device__ __forceinline__ XcdBarrier xcd_barrier_post(unsigned* bar, volatile LAS unsigned* st) {
    XcdBarrier b; b.bar = bar; b.x = xb_xcc_id(); b.st = st;
    if (threadIdx.x == 0) (void)xb_add(&bar[XB_XCNT(b.x)], 1u);
    return b;
}
__device__ __forceinline__ void xcd_barrier_complete(unsigned* bar, unsigned x, unsigned& nloc, unsigned& nx) {
    const unsigned G = gridDim.x * gridDim.y * gridDim.z;
    unsigned sum, cnt, mine, sp = 0u;
    for (;;) {
        sum = 0u; cnt = 0u; mine = 0u;
#pragma unroll
        for (unsigned j = 0; j < 16; ++j) { const unsigned c = xb_ld(&bar[XB_XCNT(j)]); sum += c; cnt += (c > 0u) ? 1u : 0u; mine = (j == x) ? c : mine; }
        if (sum == G) break;
        __builtin_amdgcn_s_sleep(1);
        if ((++sp & 255u) == 0u) { if (xb_ld(&bar[XB_TMO])) break; if (sp > XB_SPIN_CAP) { atomicAdd(&bar[XB_TMO], 1u); break; } }
    }
    nloc = mine > 0u ? mine : 1u; nx = cnt > 0u ? cnt : 1u;
}

__device__ __forceinline__ void xcd_barrier(const XcdBarrier& b) {
    asm volatile("s_waitcnt vmcnt(0)" ::: "memory");
    __syncthreads();
    if (threadIdx.x == 0) {
        unsigned* bar = b.bar;
        __builtin_amdgcn_s_waitcnt(0);
        unsigned nloc = b.st[0], nx = b.st[1];
        if (nloc == 0u) { xcd_barrier_complete(bar, b.x, nloc, nx); b.st[0] = nloc; b.st[1] = nx; }
        const unsigned old = xb_add(&bar[XB_XSUB(b.x)], 1u);
        const unsigned gen = old / nloc;
        if (old + 1u == (gen + 1u) * nloc) {
            __builtin_amdgcn_fence(__ATOMIC_RELEASE, "agent");
            asm volatile("s_waitcnt vmcnt(0)" ::: "memory");
            const unsigned og = xb_add(&bar[XB_TOP], 1u);
            const unsigned tg = og / nx;
            if (og + 1u == (tg + 1u) * nx) xb_add(&bar[XB_TOPGEN], 1u);
            else XB_SPIN(xb_ld(&bar[XB_TOPGEN]) == tg, bar);
            __builtin_amdgcn_fence(__ATOMIC_ACQUIRE, "agent");
            xb_add(&bar[XB_XGEN(b.x)], 1u);
            asm volatile("s_waitcnt vmcnt(0)" ::: "memory");
        } else {
            XB_SPIN(xb_ld(&bar[XB_XGEN(b.x)]) == gen, bar);
            __builtin_amdgcn_fence(__ATOMIC_ACQUIRE, "agent");
            asm volatile("s_waitcnt vmcnt(0)" ::: "memory");
        }
    }
    __syncthreads();
}

template <class Epi> DI void run_gemm(const Ctx& F, const bf16_t* A, const bf16_t* Bt, int M, int N, int K, const Epi& E) {
    pg8::Gemm g{A, Bt, M, N, K}; pg8::StaticOrder S; S.init(M, N, F.G, (int)blockIdx.x);
    pg8::gemm_phase<Epi, pg8::StaticOrder, Epi::ALIGN, true>(F.lds, g, S, E, F.wave);
}
constexpr int N_PHASES = 2 + 8 * 4;
#ifndef ENMASK
#define ENMASK 0xff
#endif
#define EN(k) (((ENMASK) >> (k)) & 1)
#ifndef PROBE_DUP
#define PROBE_DUP 0
#endif
#define DUP(k) ((((PROBE_DUP) >> (k)) & 1) ? 2 : 1)
__global__ void __launch_bounds__(NTHREADS, 2) mk_fwd(Args args) {
    extern __shared__ __attribute__((aligned(16))) unsigned char lds_raw[];
    cg::grid_group grid = cg::this_grid();
    volatile LAS unsigned* bar_st = (volatile LAS unsigned*)((LAS unsigned char*)lds_raw + LDS_BYTES - 16);
    if (threadIdx.x == 0) { bar_st[0] = 0u; bar_st[1] = 0u; }
    __syncthreads();
    XcdBarrier xbar = xcd_barrier_post((unsigned*)(args.ws + WS_BAR), bar_st);
    Ctx F;
    F.in = (const float* const __attribute__((address_space(4)))*)__builtin_amdgcn_kernarg_segment_ptr();
    F.out = args.out; F.ws = args.ws; F.lds = (LAS unsigned char*)lds_raw;
    const int wave0 = __builtin_amdgcn_readfirstlane((int)threadIdx.x >> 6);
    F.wave = 0; F.gw = 0; F.G = gridDim.x; F.ngw = F.G * NWAVES;
    bf16_t *H, *Y, *BIG; const bf16_t *win_t, *wout_t, *wgu_t, *wdn_t;
    for (int ph = args.ph_lo; ph < args.ph_hi; ++ph) {
        {
            unsigned char* ws_o = args.ws; float* out_o = args.out; int wv_o = wave0; asm volatile("" : "+s"(ws_o), "+s"(out_o), "+s"(wv_o));
            F.wave = wv_o; F.gw = blockIdx.x * NWAVES + F.wave; F.ws = ws_o; F.out = out_o;
            H = (bf16_t*)(F.ws + WS_H); Y = (bf16_t*)(F.ws + WS_Y); BIG = (bf16_t*)(F.ws + WS_BIG);
            win_t = (const bf16_t*)(F.ws + WS_WIN); wout_t = (const bf16_t*)(F.ws + WS_WOUT); wgu_t = (const bf16_t*)(F.ws + WS_WGU); wdn_t = (const bf16_t*)(F.ws + WS_WDN);
        }
        if (ph == 0) { for (int rep = 0; rep < DUP(3); ++rep) { if (EN(0)) modvec_phase(F); if (EN(1)) wconv_layer(F, 0); if (rep + 1 < DUP(3)) grid.sync(); } }
        else if (ph == 1) { for (int rep = 0; rep < DUP(4); ++rep) { if (EN(2)) rowwise_phase(F, 0, 0, T_ALL); if (rep + 1 < DUP(4)) grid.sync(); } }
        else {
            const int l = (ph - 2) >> 3, sub = (ph - 2) & 7; const bool odd = l & 1; const int Mr = (l == 3) ? T_LAT : T_ALL;
            int gk = 0, gM = 0, gN = 0, gK = 0, gld = 0; const bf16_t* gA = nullptr; const bf16_t* gB = nullptr; bf16_t* gO = nullptr;
            switch (sub) {
            case 0: gk = 1; gA = H; gB = win_t; gO = BIG; gM = T_ALL; gN = odd ? GDN_W : ATT_W; gK = DM; gld = gN; break;
            case 1: if (odd) { if (EN(6)) for (int rep = 0; rep < DUP(2); ++rep) { gdn_scan_phase(F, l); if (rep + 1 < DUP(2)) grid.sync(); } } else { if (EN(4)) attn_prep_phase(F, l >> 1); } break;
            case 2: if (odd) { if (EN(7)) gdn_readout_phase(F, l, Mr); } else { if (EN(5)) for (int rep = 0; rep < DUP(1); ++rep) { attn_phase(F, l); if (rep + 1 < DUP(1)) grid.sync(); } } break;
            case 3: gk = 1; gA = H; gB = wout_t; gO = Y; gM = Mr; gN = DM; gK = DM; gld = DM; break;
            case 4: if (EN(2)) rowwise_phase(F, 1, l, Mr); break;
            case 5: gk = 2; gA = H; gB = wgu_t; gO = BIG; gM = Mr; gN = 2 * FFH; gK = DM; gld = FFH; break;
            case 6: gk = 1; gA = BIG; gB = wdn_t; gO = Y; gM = Mr; gN = DM; gK = FFH; gld = DM; break;
            default: if (EN(2)) rowwise_phase(F, 2, l, Mr); if (EN(1) && l < 3) wconv_layer(F, l + 1); break;
            }
            if (EN(3)) for (int rep = 0; rep < DUP(0); ++rep) {
                if (gk == 1) { pg8::EpiStore E{gO, gld, (sub == 0 && !odd) ? 1 : 0}; run_gemm(F, gA, gB, gM, gN, gK, E); }
                else if (gk == 2) { pg8::EpiSwiglu E{gO, gld}; run_gemm(F, gA, gB, gM, gN, gK, E); }
                if (rep + 1 < DUP(0)) grid.sync();
            }
        }
        if (ph + 1 < args.ph_hi) { if (ph == args.ph_lo) grid.sync(); else xcd_barrier(xbar); if (DUP(5) == 2) xcd_barrier(xbar); }
    }
}

extern "C" void kernel_launch(void* const* d_in, const int* in_sizes, int n_in, void* d_out, int out_size, void* d_ws, size_t ws_size, hipStream_t stream) {
    static int grid = 0;
    if (grid == 0) {
        if (n_in != 20 || out_size != T_LAT * DM || ws_size < WS_END) { fprintf(stderr, "kernel_launch: unexpected problem shape (n_in %d out %d ws %zu)\n", n_in, out_size, ws_size); grid = -1; return; }
        int dev = 0, cus = 0, per_cu = 0;
        (void)hipGetDevice(&dev); (void)hipDeviceGetAttribute(&cus, hipDeviceAttributeMultiprocessorCount, dev);
        if (hipFuncSetAttribute((const void*)mk_fwd, hipFuncAttributeMaxDynamicSharedMemorySize, LDS_BYTES) != hipSuccess) { fprintf(stderr, "kernel_launch: hipFuncSetAttribute failed\n"); grid = -1; return; }
        if (hipOccupancyMaxActiveBlocksPerMultiprocessor(&per_cu, (const void*)mk_fwd, NTHREADS, LDS_BYTES) != hipSuccess || per_cu < 1) { fprintf(stderr, "kernel_launch: occupancy query says %d\n", per_cu); per_cu = 1; }
        (void)hipGetLastError();
        grid = cus * per_cu;
    }
    if (grid < 0) return;
    if (hipMemsetAsync((char*)d_ws + WS_BAR, 0, XCD_BAR_WORDS * 4, stream) != hipSuccess) { fprintf(stderr, "kernel_launch: memset of the barrier words failed\n"); return; }
    Args a{};
    for (int i = 0; i < 20; ++i) a.in[i] = (const float*)d_in[i];
    a.out = (float*)d_out; a.ws = (unsigned char*)d_ws; a.ph_lo = 0; a.ph_hi = N_PHASES;
    void* kargs[] = {&a};
    hipError_t e = hipLaunchCooperativeKernel((const void*)mk_fwd, dim3(grid), dim3(NTHREADS), kargs, LDS_BYTES, stream);
    if (e != hipSuccess) fprintf(stderr, "cooperative launch failed: %s (grid %d)\n", hipGetErrorString(e), grid);
}
```

```cpp
#include <hip/hip_runtime.h>
#include <hip/hip_cooperative_groups.h>
#include <cstdio>
#include <cstdint>
namespace cg = cooperative_groups;
namespace pg8 {
#define PG8_LAS __attribute__((address_space(3)))
typedef unsigned short bf16_t;
typedef short bf16x8 __attribute__((ext_vector_type(8)));
typedef float f32x4 __attribute__((ext_vector_type(4)));
typedef unsigned u32x4 __attribute__((ext_vector_type(4)));
constexpr int BM = 256, BK = 64, HALF = 128, HTB = HALF * BK * 2  , STAGE_BYTES = 8 * HTB, NXCD = 8, WGM = 8;

__host__ __device__ __forceinline__ int lds_byte(int r, int c) { const int st = (r >> 4) * 2 + (c >> 5), rr = r & 15, cc = c & 31, ob = rr * 64 + cc * 2; return st * 1024 + (ob ^ (((ob >> 9) & 1) << 5)); }
__host__ __device__ __forceinline__ void stage_rc(int b, int& R, int& C) { const int st = b / 1024, sb = b % 1024, swz = sb ^ (((sb >> 9) & 1) << 5); R = (st >> 1) * 16 + swz / 64; C = (st & 1) * 32 + (swz % 64) / 2; }
__host__ __device__ __forceinline__ int perm32(int rho) { const int n = rho >> 4, i = rho & 15; return 8 * (i >> 2) + 4 * n + (i & 3); }

struct Unit { int pm, pn; };
struct Gemm { const bf16_t* A; const bf16_t* Bt; int M, N, K; };

struct StaticOrder {
    int nM, nN, nwg, G, c;
    __host__ __device__ void init(int M, int N, int G_, int c_) { nM = M / BM; nN = N / BM; nwg = nM * nN; G = G_; c = c_; }
    __host__ __device__ bool next(int i, Unit& u) const {
        const long L = (long)i * G + c; if (L >= nwg) return false;
        int wgid = (int)L; { const int q = nwg / NXCD, r = nwg % NXCD, xcd = wgid % NXCD, off = wgid / NXCD; wgid = (xcd < r ? xcd * (q + 1) : r * (q + 1) + (xcd - r) * q) + off; }
        const int nig = WGM * nN, gid = wgid / nig, fm = gid * WGM, gsz = (nM - fm) < WGM ? (nM - fm) : WGM;
        u.pm = fm + ((wgid % nig) % gsz); u.pn = (wgid % nig) / gsz; return true;
    }
    __device__ __forceinline__ void a_ready(const Unit&) const {}
    __device__ __forceinline__ void done(const Unit&) const {}
};

typedef float f32x2 __attribute__((ext_vector_type(2)));
typedef __bf16 bf16x2_t __attribute__((ext_vector_type(2)));
__device__ __forceinline__ unsigned cvt_pk_bf16(float lo, float hi) { f32x2 v = {lo, hi}; bf16x2_t b = __builtin_convertvector(v, bf16x2_t); return __builtin_bit_cast(unsigned, b); }
__device__ __forceinline__ float silu_f(float x) { return x * __builtin_amdgcn_rcpf(1.0f + __expf(-x)); }
__device__ __forceinline__ float lane32_other(float v, int hh) { auto rr = __builtin_amdgcn_permlane32_swap(__builtin_bit_cast(unsigned, v), __builtin_bit_cast(unsigned, v), false, false); return __builtin_bit_cast(float, hh ? rr[0] : rr[1]); }
struct EpiStore {
    static constexpr bool PERM = true, AFTER_DRAIN = false, ALIGN = true;
    bf16_t* O; int ldc; int rope;
    __device__ __forceinline__ void operator()(const f32x4 (&acc)[2][2][4][2], const Unit& u, int wr, int wc, int fr, int fq) const {
        const int row0 = u.pm * BM + wr * 64 + fr; const int col0 = u.pn * BM + wc * 32 + 8 * fq;
        const bool dorope = rope && (u.pn == 2 || u.pn == 3) && (u.pm * BM < 65536);
        float invf[8];
#pragma unroll
        for (int j = 0; j < 8; ++j) invf[j] = __builtin_amdgcn_exp2f(-(float)(2 * (8 * (fq & 1) + j)) * (13.287712379549449f / 32.0f));
        const float sgn = (fq & 2) ? 1.0f : -1.0f;
#pragma unroll
        for (int ai = 0; ai < 2; ++ai)
#pragma unroll
            for (int m = 0; m < 4; ++m) { const int row = row0 + ai * HALF + m * 16; bf16_t* rowp = O + (size_t)row * ldc + col0;
                float cs[8], sn[8];
                if (dorope) { const int t = row & 2047; const float pos = (float)((wc & 1) ? (t & 63) : (t >> 6));
#pragma unroll
                    for (int j = 0; j < 8; ++j) { cs[j] = __cosf(pos * invf[j]); sn[j] = __sinf(pos * invf[j]); } }
#pragma unroll
                for (int bj = 0; bj < 2; ++bj) { f32x4 v0 = acc[ai][bj][m][0], v1 = acc[ai][bj][m][1];
                    if (ldc == 4352 && u.pn == 16 && (bj != 0 || wc != 0)) continue;
                    if (dorope) {
#pragma unroll
                        for (int j = 0; j < 4; ++j) { const float p0 = lane32_other(v0[j], fq >> 1), p1 = lane32_other(v1[j], fq >> 1);
                            v0[j] = v0[j] * cs[j] + sgn * p0 * sn[j]; v1[j] = v1[j] * cs[4 + j] + sgn * p1 * sn[4 + j]; } }
                    u32x4 w; w.x = cvt_pk_bf16(v0[0], v0[1]); w.y = cvt_pk_bf16(v0[2], v0[3]); w.z = cvt_pk_bf16(v1[0], v1[1]); w.w = cvt_pk_bf16(v1[2], v1[3]);
                    *(u32x4*)(rowp + bj * HALF) = w; } }
    }
};
struct EpiSwiglu {
    static constexpr bool PERM = true, AFTER_DRAIN = false, ALIGN = true;
    bf16_t* O; int ldc;
    __device__ __forceinline__ void operator()(const f32x4 (&acc)[2][2][4][2], const Unit& u, int wr, int wc, int fr, int fq) const {
        const int row0 = u.pm * BM + wr * 64 + fr; const int col0 = u.pn * HALF + wc * 32 + 8 * fq;
#pragma unroll
        for (int ai = 0; ai < 2; ++ai)
#pragma unroll
            for (int m = 0; m < 4; ++m) { bf16_t* rowp = O + (size_t)(row0 + ai * HALF + m * 16) * ldc + col0;
                const f32x4 g0 = acc[ai][0][m][0], g1 = acc[ai][0][m][1], u0 = acc[ai][1][m][0], u1 = acc[ai][1][m][1];
                u32x4 w; w.x = cvt_pk_bf16(silu_f(g0[0]) * u0[0], silu_f(g0[1]) * u0[1]); w.y = cvt_pk_bf16(silu_f(g0[2]) * u0[2], silu_f(g0[3]) * u0[3]);
                w.z = cvt_pk_bf16(silu_f(g1[0]) * u1[0], silu_f(g1[1]) * u1[1]); w.w = cvt_pk_bf16(silu_f(g1[2]) * u1[2], silu_f(g1[3]) * u1[3]);
                __builtin_nontemporal_store(w, (u32x4*)rowp); }
    }
};

template <class Epi, class Sched, bool ALIGN_EPI = false, bool SP2 = false>
__device__ __forceinline__ void gemm_phase(PG8_LAS unsigned char* lds, const Gemm g, const Sched& S, const Epi& E, int wave_id) {
    int lane_; asm volatile("v_mbcnt_lo_u32_b32 %0, -1, 0\n\tv_mbcnt_hi_u32_b32 %0, -1, %0" : "=v"(lane_)); const int tid_ = wave_id * 64 + lane_;
    const int tid = tid_, wid = __builtin_amdgcn_readfirstlane(tid >> 6), lane = tid & 63, wr = wid >> 2, wc = wid & 3, fr = lane & 15, fq = lane >> 4;
    const int K = g.K, nt = K / BK;
    unsigned voffA[2], voffB[2];
#pragma unroll
    for (int i = 0; i < 2; ++i) { int R, C; stage_rc(tid * 16 + i * 8192, R, C); const int Rb = Epi::PERM ? ((R & ~31) + perm32(R & 31)) : R;
        voffA[i] = (unsigned)(R * K + C) * 2u; voffB[i] = (unsigned)(Rb * K + C) * 2u; }
    const size_t kstep = (size_t)(BK * 2);
    const size_t hstep = (size_t)HALF * K * 2;
    const size_t tstep = 2 * hstep;
    const unsigned ldsw = (unsigned)wid * 1024u;
    const int aoff = lds_byte(wr * 64 + fr, fq * 8), boff = lds_byte(wc * 32 + fr, fq * 8);
#define PG8_SA(b, h) (((b) * 2 + (h)) * HTB)
#define PG8_SB(b, h) ((4 + (b) * 2 + (h)) * HTB)
#define PG8_STAGE(bufoff, gbase, voff) do { _Pragma("unroll") for (int _i = 0; _i < 2; ++_i) \
        __builtin_amdgcn_global_load_lds((const unsigned*)((const char*)(gbase) + (voff)[_i]), (PG8_LAS unsigned*)(lds + (bufoff) + ldsw + _i * 8192), 16, 0, 0); } while (0)
#define PG8_LDA(dst, b, h) do { _Pragma("unroll") for (int m = 0; m < 4; ++m) _Pragma("unroll") for (int k = 0; k < 2; ++k) dst[m][k] = *(const PG8_LAS bf16x8*)(lds + PG8_SA(b, h) + aoff + m * 2048 + k * 1024); } while (0)
#define PG8_LDB(dst, b, h) do { _Pragma("unroll") for (int n = 0; n < 2; ++n) _Pragma("unroll") for (int k = 0; k < 2; ++k) dst[n][k] = *(const PG8_LAS bf16x8*)(lds + PG8_SB(b, h) + boff + n * 2048 + k * 1024); } while (0)
#define PG8_MMA(ai, bj, At, Bt) do { __builtin_amdgcn_s_setprio(1); _Pragma("unroll") for (int m = 0; m < 4; ++m) _Pragma("unroll") for (int n = 0; n < 2; ++n) _Pragma("unroll") for (int k = 0; k < 2; ++k) \
        acc[ai][bj][m][n] = __builtin_amdgcn_mfma_f32_16x16x32_bf16(Bt[n][k], At[m][k], acc[ai][bj][m][n], 0, 0, 0); __builtin_amdgcn_s_setprio(0); } while (0)
#define PG8_WAIT_V(n) asm volatile("s_waitcnt vmcnt(" #n ")" ::: "memory")
#define PG8_WAIT_L(n) asm volatile("s_waitcnt lgkmcnt(" #n ")" ::: "memory")
#define PG8_BAR __builtin_amdgcn_s_barrier()
#define PG8_SCHED __builtin_amdgcn_sched_barrier(0)
    Unit cur, nxt; int ui = 0;
    if (!S.next(0, cur)) return;
    f32x4 acc[2][2][4][2];
#pragma unroll
    for (int a = 0; a < 2; ++a)
#pragma unroll
        for (int b = 0; b < 2; ++b)
#pragma unroll
            for (int m = 0; m < 4; ++m)
#pragma unroll
                for (int n = 0; n < 2; ++n) acc[a][b][m][n] = (f32x4){0.f, 0.f, 0.f, 0.f};
    bf16x8 At[4][2], B0[2][2], B1[2][2];
    const char* cA = (const char*)g.A + (size_t)cur.pm * tstep; const char* cB = (const char*)g.Bt + (size_t)cur.pn * tstep;
    S.a_ready(cur);
    if constexpr (SP2) {
        PG8_STAGE(PG8_SB(0, 0), cB, voffB); PG8_STAGE(PG8_SB(0, 1), cB + hstep, voffB); PG8_STAGE(PG8_SA(0, 0), cA, voffA); PG8_STAGE(PG8_SA(0, 1), cA + hstep, voffA);
        if (wr == 1) PG8_BAR;
        PG8_WAIT_V(2); PG8_BAR;
        PG8_STAGE(PG8_SB(1, 0), cB + kstep, voffB); PG8_STAGE(PG8_SA(1, 0), cA + kstep, voffA); PG8_STAGE(PG8_SB(1, 1), cB + hstep + kstep, voffB);
        PG8_WAIT_V(6); PG8_BAR;
    } else {
        PG8_STAGE(PG8_SB(0, 0), cB, voffB); PG8_STAGE(PG8_SA(0, 0), cA, voffA); PG8_STAGE(PG8_SB(0, 1), cB + hstep, voffB); PG8_STAGE(PG8_SA(0, 1), cA + hstep, voffA);
        if (wr == 1) PG8_BAR;
        PG8_WAIT_V(4); PG8_BAR;
        PG8_STAGE(PG8_SB(1, 0), cB + kstep, voffB); PG8_STAGE(PG8_SA(1, 0), cA + kstep, voffA); PG8_STAGE(PG8_SB(1, 1), cB + hstep + kstep, voffB);
        PG8_WAIT_V(6); PG8_BAR;
    }
    for (;;) {
        const bool has_next = S.next(ui + 1, nxt);
        const char* nA = has_next ? (const char*)g.A + (size_t)nxt.pm * tstep : cA; const char* nB = has_next ? (const char*)g.Bt + (size_t)nxt.pn * tstep : cB;
        for (int t = 0; t < nt; t += 2) {
            const bool last = (t == nt - 2);
            const char* a1 = cA + (size_t)(t + 1) * kstep;
            const char* a2 = last ? nA : cA + (size_t)(t + 2) * kstep; const char* b2 = last ? nB : cB + (size_t)(t + 2) * kstep;
            const char* a3 = a2 + kstep; const char* b3 = b2 + kstep;
            if (last && has_next) S.a_ready(nxt);
            if constexpr (SP2) {
            PG8_LDB(B0, 0, 0); PG8_LDB(B1, 0, 1); PG8_SCHED; PG8_LDA(At, 0, 0); PG8_STAGE(PG8_SA(1, 1), a1 + hstep, voffA);
            PG8_WAIT_V(8); PG8_WAIT_L(0); PG8_BAR; PG8_MMA(0, 0, At, B0); PG8_MMA(0, 1, At, B1); PG8_BAR; PG8_SCHED;
            PG8_LDA(At, 0, 1); PG8_STAGE(PG8_SB(0, 0), b2, voffB); PG8_STAGE(PG8_SB(0, 1), b2 + hstep, voffB); PG8_STAGE(PG8_SA(0, 0), a2, voffA);
            PG8_WAIT_V(8); PG8_WAIT_L(0); PG8_BAR; PG8_MMA(1, 0, At, B0); PG8_MMA(1, 1, At, B1); PG8_BAR; PG8_SCHED;
            PG8_LDB(B0, 1, 0); PG8_LDB(B1, 1, 1); PG8_SCHED; PG8_LDA(At, 1, 0); PG8_STAGE(PG8_SA(0, 1), a2 + hstep, voffA);
            PG8_WAIT_V(8); PG8_WAIT_L(0); PG8_BAR; PG8_MMA(0, 0, At, B0); PG8_MMA(0, 1, At, B1); PG8_BAR; PG8_SCHED;
            PG8_LDA(At, 1, 1); PG8_STAGE(PG8_SB(1, 0), b3, voffB); PG8_STAGE(PG8_SB(1, 1), b3 + hstep, voffB); PG8_STAGE(PG8_SA(1, 0), a3, voffA);
            PG8_WAIT_V(8); PG8_WAIT_L(0); PG8_BAR; PG8_MMA(1, 0, At, B0); PG8_MMA(1, 1, At, B1); PG8_BAR; PG8_SCHED;
            } else {
            PG8_LDB(B0, 0, 0); PG8_SCHED; PG8_LDA(At, 0, 0); PG8_STAGE(PG8_SA(1, 1), a1 + hstep, voffA);
            PG8_WAIT_L(8); PG8_BAR; PG8_WAIT_L(0); PG8_MMA(0, 0, At, B0); PG8_BAR; PG8_SCHED;
            PG8_LDB(B1, 0, 1); PG8_STAGE(PG8_SB(0, 0), b2, voffB);
            PG8_BAR; PG8_WAIT_L(0); PG8_MMA(0, 1, At, B1); PG8_BAR;
            PG8_LDA(At, 0, 1); PG8_STAGE(PG8_SA(0, 0), a2, voffA);
            PG8_BAR; PG8_WAIT_L(0); PG8_MMA(1, 0, At, B0); PG8_BAR; PG8_SCHED;
            PG8_STAGE(PG8_SB(0, 1), b2 + hstep, voffB);
            PG8_WAIT_V(6); PG8_BAR; PG8_MMA(1, 1, At, B1); PG8_BAR;
            PG8_LDB(B0, 1, 0); PG8_SCHED; PG8_LDA(At, 1, 0); PG8_STAGE(PG8_SA(0, 1), a2 + hstep, voffA);
            PG8_WAIT_L(8); PG8_BAR; PG8_WAIT_L(0); PG8_MMA(0, 0, At, B0); PG8_BAR; PG8_SCHED;
            PG8_LDB(B1, 1, 1); PG8_STAGE(PG8_SB(1, 0), b3, voffB);
            PG8_BAR; PG8_WAIT_L(0); PG8_MMA(0, 1, At, B1); PG8_BAR;
            PG8_LDA(At, 1, 1); PG8_STAGE(PG8_SA(1, 0), a3, voffA);
            PG8_BAR; PG8_WAIT_L(0); PG8_MMA(1, 0, At, B0); PG8_BAR; PG8_SCHED;
            PG8_STAGE(PG8_SB(1, 1), b3 + hstep, voffB);
            PG8_WAIT_V(6); PG8_BAR; PG8_MMA(1, 1, At, B1); PG8_BAR;
            }
        }
        if constexpr (ALIGN_EPI) { if (wr == 0) PG8_BAR; }
        if constexpr (!Epi::AFTER_DRAIN) { E(acc, cur, wr, wc, fr, fq); S.done(cur); }
        if (!has_next) break;
#pragma unroll
        for (int a = 0; a < 2; ++a)
#pragma unroll
            for (int b = 0; b < 2; ++b)
#pragma unroll
                for (int m = 0; m < 4; ++m)
#pragma unroll
                    for (int n = 0; n < 2; ++n) acc[a][b][m][n] = (f32x4){0.f, 0.f, 0.f, 0.f};
        cur = nxt; cA = nA; cB = nB; ++ui;
        if constexpr (ALIGN_EPI) { if (wr == 1) PG8_BAR; }
    }
    PG8_WAIT_V(0);
    if constexpr (!ALIGN_EPI) { if (wr == 0) PG8_BAR; }
    PG8_BAR;
    if constexpr (Epi::AFTER_DRAIN) { E.fused(acc, cur, wr, wc, fr, fq, lds, wid, lane); S.done(cur); }
#undef PG8_SA
#undef PG8_SB
#undef PG8_STAGE
#undef PG8_LDA
#undef PG8_LDB
#undef PG8_MMA
#undef PG8_WAIT_V
#undef PG8_WAIT_L
#undef PG8_BAR
#undef PG8_SCHED
}
}
#define LAS __attribute__((address_space(3)))
#define DI __device__ __forceinline__
typedef unsigned short bf16_t;
typedef short bf16x8 __attribute__((ext_vector_type(8)));
typedef short s16x4 __attribute__((ext_vector_type(4)));
typedef float f32x4 __attribute__((ext_vector_type(4)));
typedef float f32x16 __attribute__((ext_vector_type(16)));
typedef unsigned u32x4 __attribute__((ext_vector_type(4)));
typedef unsigned u32x2 __attribute__((ext_vector_type(2)));
typedef float f32x2 __attribute__((ext_vector_type(2)));
using pg8::cvt_pk_bf16;
using pg8::silu_f;

constexpr int NTHREADS = 512, NWAVES = 8;
constexpr int DM = 1024, T_LAT = 65536, T_CTX = 8192, T_ALL = T_LAT + T_CTX, SEQ = 2048, CTXL = 256, NB = 32;
constexpr int ATT_W = 2304, GDN_W = 4352, GDN_WREAL = 4128, FFH = 2816;
constexpr float RMS_EPS = 1e-6f;
constexpr int LDS_BYTES = 163840;
constexpr size_t MiB = 1u << 20;
constexpr size_t WS_BAR = 3670016;
constexpr size_t WS_MOD = 0, WS_WIN = 4 * MiB, WS_WOUT = 13 * MiB, WS_WGU = 15 * MiB, WS_WDN = 26 * MiB, WS_XCTX = 32 * MiB, WS_H = 64 * MiB, WS_Y = 208 * MiB, WS_BIG = 352 * MiB, WS_END = 964 * MiB;

struct Args { const float* in[20]; float* out; unsigned char* ws; int ph_lo, ph_hi; };
enum { I_X = 0, I_C, I_CTX, I_CCTX, I_ADAW, I_ADAB, I_NORMG, I_AWIN, I_AWOUT, I_DLAM, I_SUBLN, I_QKG, I_GWIN, I_GCONV, I_GALOG, I_GDT, I_GNORM, I_GWOUT, I_FGU, I_FDN };

DI float bf2f(bf16_t b) { return __uint_as_float((unsigned)b << 16); }
DI float bflo(unsigned u) { return __uint_as_float(u << 16); }
DI float bfhi(unsigned u) { return __uint_as_float(u & 0xffff0000u); }
DI bf16_t f2bf(float f) { return (bf16_t)(cvt_pk_bf16(f, 0.f) & 0xffffu); }
template <int OFF> DI float shx(float v) { return __int_as_float(__builtin_amdgcn_ds_swizzle(__float_as_int(v), (OFF << 10) | 0x1f)); }
DI float swp_other(float v, int h) { auto rr = __builtin_amdgcn_permlane32_swap(__float_as_uint(v), __float_as_uint(v), false, false); return __uint_as_float(h ? rr[0] : rr[1]); }
DI float swp_sum(float v) { auto rr = __builtin_amdgcn_permlane32_swap(__float_as_uint(v), __float_as_uint(v), false, false); return __uint_as_float(rr[0]) + __uint_as_float(rr[1]); }
DI float swp_max(float v) { auto rr = __builtin_amdgcn_permlane32_swap(__float_as_uint(v), __float_as_uint(v), false, false); return fmaxf(__uint_as_float(rr[0]), __uint_as_float(rr[1])); }
DI float wave_sum(float v) { v += shx<1>(v); v += shx<2>(v); v += shx<4>(v); v += shx<8>(v); v += shx<16>(v); return swp_sum(v); }
#define MFMA32(a, b, c) __builtin_amdgcn_mfma_f32_32x32x16_bf16((a), (b), (c), 0, 0, 0)
DI int crow(int r, int h) { return (r & 3) + 8 * (r >> 2) + 4 * h; }
template <int S> DI bf16x8 pack_step(const f32x16& x) {
    u32x4 p; p.x = cvt_pk_bf16(x[8 * S], x[8 * S + 1]); p.y = cvt_pk_bf16(x[8 * S + 2], x[8 * S + 3]); p.z = cvt_pk_bf16(x[8 * S + 4], x[8 * S + 5]); p.w = cvt_pk_bf16(x[8 * S + 6], x[8 * S + 7]);
    return __builtin_bit_cast(bf16x8, p);
}
typedef short v4i16_t __attribute__((ext_vector_type(4)));
DI s16x4 tr_read(LAS const unsigned char* p) { return __builtin_bit_cast(s16x4, __builtin_amdgcn_ds_read_tr16_b64_v4i16((LAS v4i16_t*)p)); }
DI bf16x8 cat8(s16x4 lo, s16x4 hi) { return __builtin_shufflevector(lo, hi, 0, 1, 2, 3, 4, 5, 6, 7); }

struct Ctx {
    const float* const __attribute__((address_space(4)))* in; float* out; unsigned char* ws;
    LAS unsigned char* lds; int wave, G, gw, ngw;
};
DI int get_lane() { int l; asm volatile("v_mbcnt_lo_u32_b32 %0, -1, 0\n\tv_mbcnt_hi_u32_b32 %0, -1, %0" : "=v"(l)); return l; }
#define PHASE_IDS const int LANE = get_lane(); const int TID = F.wave * 64 + LANE; (void)TID;

DI float* xrow(const Ctx& F, int m) { return m < T_LAT ? F.out + (size_t)m * DM : (float*)(F.ws + WS_XCTX) + (size_t)(m - T_LAT) * DM; }
DI const float* xin(const Ctx& F, int m) { return m < T_LAT ? F.in[I_X] + (size_t)m * DM : F.in[I_CTX] + (size_t)(m - T_LAT) * DM; }

DI void transpose_item(const float* W, int K, int N, bf16_t* WT, int k0, int n0, int drow0, LAS float* scr, int lane) {
#pragma unroll 8
    for (int i = 0; i < 32; ++i) { const int kk = 2 * i + (lane >> 5); scr[kk * 33 + (lane & 31)] = __builtin_nontemporal_load(W + (size_t)(k0 + kk) * N + n0 + (lane & 31)); }
    asm volatile("s_waitcnt lgkmcnt(0)" ::: "memory");
    const int c = lane & 7;
#pragma unroll
    for (int j = 0; j < 4; ++j) { const int n = (lane >> 3) + 8 * j; const LAS float* s = scr + (8 * c) * 33 + n;
        u32x4 o; o.x = cvt_pk_bf16(s[0 * 33], s[1 * 33]); o.y = cvt_pk_bf16(s[2 * 33], s[3 * 33]); o.z = cvt_pk_bf16(s[4 * 33], s[5 * 33]); o.w = cvt_pk_bf16(s[6 * 33], s[7 * 33]);
        *(u32x4*)(WT + (size_t)(drow0 + n) * K + k0 + 8 * c) = o; }
    asm volatile("s_waitcnt lgkmcnt(0)" ::: "memory");
}
DI void wconv_layer(const Ctx& F, int l) {
    PHASE_IDS
    LAS float* scr = (LAS float*)(F.lds + F.wave * 8448);
    const int i2 = l >> 1; const bool odd = l & 1;
    const float* Win = odd ? F.in[I_GWIN] + (size_t)i2 * DM * GDN_WREAL : F.in[I_AWIN] + (size_t)i2 * DM * ATT_W;
    const float* Wout = odd ? F.in[I_GWOUT] + (size_t)i2 * DM * DM : F.in[I_AWOUT] + (size_t)i2 * DM * DM;
    const float* Wgu = F.in[I_FGU] + (size_t)l * DM * 2 * FFH; const float* Wdn = F.in[I_FDN] + (size_t)l * FFH * DM;
    bf16_t* win_t = (bf16_t*)(F.ws + WS_WIN); bf16_t* wout_t = (bf16_t*)(F.ws + WS_WOUT); bf16_t* wgu_t = (bf16_t*)(F.ws + WS_WGU); bf16_t* wdn_t = (bf16_t*)(F.ws + WS_WDN);
    const int Nin = odd ? GDN_WREAL : ATT_W;
    const int n_in = 16 * (Nin / 32), n_out = 16 * 32, n_gu = 16 * (2 * FFH / 32), n_dn = (FFH / 64) * 32, n_zero = odd ? (GDN_W - GDN_WREAL) : 0;
    const int total = n_in + n_out + n_gu + n_dn + n_zero;
    for (int it = F.gw; it < total; it += F.ngw) {
        int r = it;
        if (r < n_in) { const int nb = Nin / 32, kb = r / nb, nn = r % nb; transpose_item(Win, DM, Nin, win_t, 64 * kb, 32 * nn, 32 * nn, scr, LANE); continue; } r -= n_in;
        if (r < n_out) { const int kb = r / 32, nn = r % 32; transpose_item(Wout, DM, DM, wout_t, 64 * kb, 32 * nn, 32 * nn, scr, LANE); continue; } r -= n_out;
        if (r < n_gu) { const int nb = 2 * FFH / 32, kb = r / nb, nn = r % nb; const int n0 = 32 * nn, half = n0 / FFH, jj = n0 % FFH; const int drow = (jj / 128) * 256 + half * 128 + (jj % 128);
            transpose_item(Wgu, DM, 2 * FFH, wgu_t, 64 * kb, n0, drow, scr, LANE); continue; } r -= n_gu;
        if (r < n_dn) { const int kb = r / 32, nn = r % 32; transpose_item(Wdn, FFH, DM, wdn_t, 64 * kb, 32 * nn, 32 * nn, scr, LANE); continue; } r -= n_dn;
        { u32x4 z = {0u, 0u, 0u, 0u}; u32x4* p = (u32x4*)(win_t + (size_t)(GDN_WREAL + r) * DM); p[LANE] = z; p[LANE + 64] = z; }
    }
}

DI void modvec_phase(const Ctx& F) {
    PHASE_IDS
    LAS float* sc = (LAS float*)F.lds;
    float* MOD = (float*)(F.ws + WS_MOD);
    for (int it = blockIdx.x; it < 4 * 96; it += F.G) {
        for (int idx = TID; idx < 33 * 1024; idx += NTHREADS) { const int bb = idx >> 10, k = idx & 1023; const float v = bb < 32 ? F.in[I_C][bb * 1024 + k] : F.in[I_CCTX][k]; sc[idx] = silu_f(v); }
        __syncthreads();
        const int l = it / 96, col = (it % 96) * 64 + LANE, k0 = F.wave * 128;
        const float* w = F.in[I_ADAW] + (size_t)l * DM * 6144 + col;
        float acc[33];
#pragma unroll
        for (int i = 0; i < 33; ++i) acc[i] = 0.f;
        for (int k = k0; k < k0 + 128; k += 16) {
            float wv[16];
#pragma unroll
            for (int j = 0; j < 16; ++j) wv[j] = __builtin_nontemporal_load(w + (size_t)(k + j) * 6144);
            int zd = 0;
#pragma unroll
            for (int j4 = 0; j4 < 4; ++j4) {
                const LAS unsigned char* scb = (const LAS unsigned char*)(sc + k + 4 * j4) + zd;
#pragma unroll
                for (int i = 0; i < 33; ++i) { const f32x4 s = *(const LAS f32x4*)(scb + i * 4096); acc[i] += (s[0] * wv[4 * j4] + s[1] * wv[4 * j4 + 1]) + (s[2] * wv[4 * j4 + 2] + s[3] * wv[4 * j4 + 3]); }
                asm volatile("v_and_b32 %0, 0, %1" : "=v"(zd) : "v"(acc[0]), "v"(acc[8]), "v"(acc[16]), "v"(acc[24]), "v"(acc[32]));
            }
        }
        __syncthreads();
#pragma unroll
        for (int i = 0; i < 33; ++i) sc[(F.wave * 33 + i) * 64 + LANE] = acc[i];
        __syncthreads();
        const float* bs = F.in[I_ADAB] + l * 6144 + (it % 96) * 64;
        for (int o = TID; o < 33 * 64; o += NTHREADS) { const int bb = o >> 6, c = o & 63; float sum = bs[c];
#pragma unroll
            for (int wv_ = 0; wv_ < 8; ++wv_) sum += sc[(wv_ * 33 + bb) * 64 + c];
            MOD[(size_t)(l * 33 + bb) * 6144 + (it % 96) * 64 + c] = sum; }
        __syncthreads();
    }
}

DI void rowwise_phase(const Ctx& F, int stage, int l, int Mrows) {
    PHASE_IDS
    const float* MOD = (const float*)(F.ws + WS_MOD); const float* NG = F.in[I_NORMG];
    bf16_t* H = (bf16_t*)(F.ws + WS_H); const bf16_t* Y = (const bf16_t*)(F.ws + WS_Y);
    const bool needh = !(stage == 2 && l == 3), xfromin = (stage == 0) || (stage == 1 && l == 0);
    const int lh = (stage == 2) ? l + 1 : l;
    const int rpw = (Mrows + F.ngw - 1) / F.ngw, mb = F.gw * rpw, me = (mb + rpw < Mrows) ? mb + rpw : Mrows;
    if (mb >= me) return;
    f32x4 ga[4], gb[4], gt[4], sh[4], sc[4];
#pragma unroll
    for (int j = 0; j < 4; ++j) { ga[j] = (f32x4){0.f, 0.f, 0.f, 0.f}; gb[j] = ga[j]; gt[j] = ga[j]; sh[j] = ga[j]; sc[j] = ga[j]; }
    if (stage != 0) { const float* gap = NG + (size_t)(l * 4 + (stage == 1 ? 1 : 3)) * DM;
#pragma unroll
        for (int j = 0; j < 4; ++j) ga[j] = ((const f32x4*)gap)[LANE + 64 * j]; }
    if (needh) { const float* gbp = NG + (size_t)(lh * 4 + (stage == 1 ? 2 : 0)) * DM;
#pragma unroll
        for (int j = 0; j < 4; ++j) gb[j] = ((const f32x4*)gbp)[LANE + 64 * j]; }
    int cur_bb = -1;
    bf16_t* XL = (bf16_t*)((unsigned char*)F.out + 128 * MiB); float* XF = (float*)(F.ws + WS_BIG + 352 * MiB); float* XC = (float*)(F.ws + WS_XCTX);
    f32x4 xn[2][4]; u32x2 yn[2][4], xbn[2][4];
#define RW_SRC16(m_) (!xfromin && (m_) < T_LAT && !(l == 3 && stage == 2))
#define RW_FETCH(m_, q_) do { if (RW_SRC16(m_)) { const u32x2* xb_ = (const u32x2*)(XL + (size_t)(m_) * DM) + LANE; _Pragma("unroll") for (int j = 0; j < 4; ++j) xbn[q_][j] = __builtin_nontemporal_load(xb_ + 64 * j); } \
        else { const float* xr_ = xfromin ? xin(F, (m_)) : ((m_) >= T_LAT ? XC + (size_t)((m_) - T_LAT) * DM : XF + (size_t)(m_) * DM); const f32x4* xp_ = (const f32x4*)xr_ + LANE; \
            _Pragma("unroll") for (int j = 0; j < 4; ++j) xn[q_][j] = __builtin_nontemporal_load(xp_ + 64 * j); } \
        if (stage != 0) { const u32x2* yp_ = (const u32x2*)(Y + (size_t)(m_) * DM) + LANE; _Pragma("unroll") for (int j = 0; j < 4; ++j) yn[q_][j] = __builtin_nontemporal_load(yp_ + 64 * j); } } while (0)
#pragma unroll
    for (int j = 0; j < 4; ++j) { yn[0][j] = (u32x2){0u, 0u}; xbn[0][j] = (u32x2){0u, 0u}; xn[0][j] = (f32x4){0.f, 0.f, 0.f, 0.f}; yn[1][j] = yn[0][j]; xbn[1][j] = xbn[0][j]; xn[1][j] = xn[0][j]; }
    RW_FETCH(mb, 0);
    if (mb + 1 < me) RW_FETCH(mb + 1, 1);
    for (int m0 = mb; m0 < me; m0 += 2) {
#pragma unroll
      for (int q = 0; q < 2; ++q) {
        const int m = m0 + q;
        if (m >= me) break;
        f32x4 x[4]; u32x2 yw[4];
#pragma unroll
        for (int j = 0; j < 4; ++j) { x[j] = RW_SRC16(m) ? (f32x4){bflo(xbn[q][j].x), bfhi(xbn[q][j].x), bflo(xbn[q][j].y), bfhi(xbn[q][j].y)} : xn[q][j]; yw[j] = yn[q][j]; }
        if (m + 2 < me) RW_FETCH(m + 2, q);
        const int bb = m < T_LAT ? (m >> 11) : 32;
        if (bb != cur_bb) { cur_bb = bb;
            if (stage != 0) { const float* md = MOD + (size_t)(l * 33 + bb) * 6144 + (stage == 1 ? 2 * 1024 : 5 * 1024);
#pragma unroll
                for (int j = 0; j < 4; ++j) gt[j] = ((const f32x4*)md)[LANE + 64 * j]; }
            if (needh) { const float* md = MOD + (size_t)(lh * 33 + bb) * 6144 + (stage == 1 ? 3 * 1024 : 0);
#pragma unroll
                for (int j = 0; j < 4; ++j) { sh[j] = ((const f32x4*)md)[LANE + 64 * j]; sc[j] = ((const f32x4*)(md + 1024))[LANE + 64 * j]; } }
        }
        if (stage != 0) {
            f32x4 y[4]; float ss = 0.f;
#pragma unroll
            for (int j = 0; j < 4; ++j) { y[j] = (f32x4){bflo(yw[j].x), bfhi(yw[j].x), bflo(yw[j].y), bfhi(yw[j].y)}; ss += (y[j][0] * y[j][0] + y[j][1] * y[j][1]) + (y[j][2] * y[j][2] + y[j][3] * y[j][3]); }
            const float ry = rsqrtf(wave_sum(ss) * (1.f / DM) + RMS_EPS);
#pragma unroll
            for (int j = 0; j < 4; ++j) x[j] = x[j] + gt[j] * (y[j] * ry * ga[j]);
            if (m < T_LAT && l != 3) { u32x2* xo = (u32x2*)(XL + (size_t)m * DM) + LANE;
#pragma unroll
                for (int j = 0; j < 4; ++j) { u32x2 w; w.x = cvt_pk_bf16(x[j][0], x[j][1]); w.y = cvt_pk_bf16(x[j][2], x[j][3]); __builtin_nontemporal_store(w, xo + 64 * j); } }
            else { float* xr = (m >= T_LAT) ? XC + (size_t)(m - T_LAT) * DM : (stage == 1 ? XF + (size_t)m * DM : F.out + (size_t)m * DM); f32x4* xo = (f32x4*)xr + LANE;
#pragma unroll
                for (int j = 0; j < 4; ++j) xo[64 * j] = x[j]; }
        }
        if (!needh) continue;
        float s2 = 0.f;
#pragma unroll
        for (int j = 0; j < 4; ++j) s2 += (x[j][0] * x[j][0] + x[j][1] * x[j][1]) + (x[j][2] * x[j][2] + x[j][3] * x[j][3]);
        const float rx = rsqrtf(wave_sum(s2) * (1.f / DM) + RMS_EPS);
        u32x2* hp = (u32x2*)(H + (size_t)m * DM) + LANE;
#pragma unroll
        for (int j = 0; j < 4; ++j) { const f32x4 hv = (x[j] * rx * gb[j]) * (sc[j] + 1.0f) + sh[j]; u32x2 w; w.x = cvt_pk_bf16(hv[0], hv[1]); w.y = cvt_pk_bf16(hv[2], hv[3]); hp[64 * j] = w; }
      }
    }
#undef RW_FETCH
#undef RW_SRC16
}
constexpr float QSCALE = 0.125f * 1.4426950408889634f;
DI void attn_prep_phase(const Ctx& F, int i2) {
    PHASE_IDS
    bf16_t* P = (bf16_t*)(F.ws + WS_BIG);
    const int sub = LANE & 15, hsel = LANE >> 4;
    const f32x4 qg0 = *(const f32x4*)(F.in[I_QKG] + (i2 * 2 + 0) * 64 + 4 * sub), qg1 = *(const f32x4*)(F.in[I_QKG] + (i2 * 2 + 1) * 64 + 4 * sub);
    float inv_freq[4];
#pragma unroll
    for (int e = 0; e < 4; ++e) inv_freq[e] = exp2f(-(float)(2 * (4 * (sub & 3) + e)) * (1.0f / 32.0f) * 13.287712379549449f);
    const float sgn = (sub & 4) ? 1.0f : -1.0f;
    const int rpw = (T_ALL + F.ngw - 1) / F.ngw, mb = F.gw * rpw, me = (mb + rpw < T_ALL) ? mb + rpw : T_ALL;
    u32x2 wn[7];
#define AP_FETCH(m_) do { const bf16_t* row_ = P + (size_t)(m_) * ATT_W + hsel * 64 + 4 * sub; \
        _Pragma("unroll") for (int g = 0; g < 7; ++g) { const int c0 = (g < 4) ? 256 * g : 1536 + 256 * (g - 4); wn[g] = (u32x2){0u, 0u}; if (g == 6 && hsel < 2) wn[g] = __builtin_nontemporal_load((const u32x2*)(row_ + c0)); } } while (0)
    if (mb < me) AP_FETCH(mb);
    for (int m = mb; m < me; ++m) {
        bf16_t* row = P + (size_t)m * ATT_W + hsel * 64 + 4 * sub;
        float cs[4] = {1.f, 1.f, 1.f, 1.f}, sn[4] = {0.f, 0.f, 0.f, 0.f};
        if (m < T_LAT) { const int t = m & (SEQ - 1); const float pos = (float)((sub < 8) ? (t >> 6) : (t & 63));
#pragma unroll
            for (int e = 0; e < 4; ++e) sincosf(pos * inv_freq[e], &sn[e], &cs[e]); }
        u32x2 w[7];
#pragma unroll
        for (int g = 0; g < 7; ++g) w[g] = wn[g];
        if (m + 1 < me) AP_FETCH(m + 1);
#pragma unroll
        for (int g = 0; g < 7; ++g) {
            if (g != 6) continue;
            float v[4] = {bflo(w[g].x), bfhi(w[g].x), bflo(w[g].y), bfhi(w[g].y)};
            if (g >= 4) { float ss = (v[0] * v[0] + v[1] * v[1]) + (v[2] * v[2] + v[3] * v[3]); ss += shx<1>(ss); ss += shx<2>(ss); ss += shx<4>(ss); ss += shx<8>(ss);
                const float rs = rsqrtf(ss * (1.0f / 64.0f) + RMS_EPS); const f32x4 gg = (g < 6) ? qg0 : qg1;
#pragma unroll
                for (int e = 0; e < 4; ++e) v[e] = v[e] * rs * gg[e]; }
            const float scl = (g < 2 || g == 4 || g == 5) ? QSCALE : 1.0f;
            float o[4];
#pragma unroll
            for (int e = 0; e < 4; ++e) { const float pr = shx<4>(v[e]); o[e] = (v[e] * cs[e] + sgn * pr * sn[e]) * scl; }
            const int c0 = (g < 4) ? 256 * g : 1536 + 256 * (g - 4);
            u32x2 ow; ow.x = cvt_pk_bf16(o[0], o[1]); ow.y = cvt_pk_bf16(o[2], o[3]);
            if (g < 6 || hsel < 2) *(u32x2*)(row + c0) = ow;
        }
    }
}

constexpr int AK_PITCH = 144, AK_BYTES = 64 * AK_PITCH;
template <int DVT> struct AttnGeo { static constexpr int VP = (DVT == 4) ? 320 : 192, VBYTES = 64 * VP, VOFF = 4 * AK_BYTES; };
template <int DVT>
DI void attn_pass(f32x16 (&acc)[DVT], float& lsum, const Ctx& F, const bf16_t* P, int b, bool ctxq, int qrow, int qcol, int kcol, int vcol, const float* qgam) {
    PHASE_IDS
    typedef AttnGeo<DVT> GEO;
    const int lane = LANE, tid = TID, l31 = lane & 31, h = lane >> 5;
    LAS unsigned char* lds = F.lds;
    const int nt = ctxq ? 4 : 36;
    bf16x8 qf[4];
    {
        float q[4][8];
#pragma unroll
        for (int ks = 0; ks < 4; ++ks) { const u32x4 w = __builtin_nontemporal_load((const u32x4*)(P + (size_t)qrow * ATT_W + qcol + ks * 16 + h * 8));
            q[ks][0] = bflo(w.x); q[ks][1] = bfhi(w.x); q[ks][2] = bflo(w.y); q[ks][3] = bfhi(w.y); q[ks][4] = bflo(w.z); q[ks][5] = bfhi(w.z); q[ks][6] = bflo(w.w); q[ks][7] = bfhi(w.w); }
        if (qgam) {
            float ss = 0.f;
#pragma unroll
            for (int ks = 0; ks < 4; ++ks)
#pragma unroll
                for (int j = 0; j < 8; ++j) ss += q[ks][j] * q[ks][j];
            ss = swp_sum(ss);
            const float rs = rsqrtf(ss * (1.0f / 64.0f) + RMS_EPS);
#pragma unroll
            for (int ks = 0; ks < 4; ++ks) { const f32x4 g0 = *(const f32x4*)(qgam + ks * 16 + h * 8), g1 = *(const f32x4*)(qgam + ks * 16 + h * 8 + 4);
#pragma unroll
                for (int j = 0; j < 4; ++j) { q[ks][j] *= rs * g0[j]; q[ks][4 + j] *= rs * g1[j]; } }
        }
        if (!ctxq) {
            const int tq = qrow & (SEQ - 1); const float pr = (float)(tq >> 6), pc = (float)(tq & 63);
#pragma unroll
            for (int j = 0; j < 8; ++j) {
                const float fr = exp2f(-(float)(2 * (8 * h + j)) * (1.0f / 32.0f) * 13.287712379549449f);
                const float sr = __sinf(pr * fr), cr = __cosf(pr * fr), sc_ = __sinf(pc * fr), cc = __cosf(pc * fr);
                const float a0 = q[0][j], a1 = q[1][j], b0 = q[2][j], b1 = q[3][j];
                q[0][j] = a0 * cr - a1 * sr; q[1][j] = a1 * cr + a0 * sr; q[2][j] = b0 * cc - b1 * sc_; q[3][j] = b1 * cc + b0 * sc_;
            }
        }
#pragma unroll
        for (int ks = 0; ks < 4; ++ks) { u32x4 w; w.x = cvt_pk_bf16(q[ks][0] * QSCALE, q[ks][1] * QSCALE); w.y = cvt_pk_bf16(q[ks][2] * QSCALE, q[ks][3] * QSCALE); w.z = cvt_pk_bf16(q[ks][4] * QSCALE, q[ks][5] * QSCALE); w.w = cvt_pk_bf16(q[ks][6] * QSCALE, q[ks][7] * QSCALE);
            qf[ks] = __builtin_bit_cast(bf16x8, w); }
    }
#pragma unroll
    for (int t = 0; t < DVT; ++t)
#pragma unroll
        for (int r = 0; r < 16; ++r) acc[t][r] = 0.f;
    float mrun = 0.f; lsum = 0.f;
    float nref = 0.f;
    const int krow_s = tid >> 3, kch = tid & 7;
    u32x4 kregA, vregA[DVT / 2];
#define A_ROWBASE(t) ((t) < 4 ? (T_LAT + b * CTXL + 64 * (t)) : (b * SEQ + 64 * ((t) - 4)))
#define A_GLOAD(t, kreg, vreg) do { const int rb_ = A_ROWBASE(t); kreg = *(const u32x4*)(P + (size_t)(rb_ + krow_s) * ATT_W + kcol + kch * 8); \
        if (DVT == 4) { _Pragma("unroll") for (int i_ = 0; i_ < DVT / 2; ++i_) { const int idx_ = tid + 512 * i_; vreg[i_] = *(const u32x4*)(P + (size_t)(rb_ + (idx_ >> 4)) * ATT_W + vcol + (idx_ & 15) * 8); } } \
        else { vreg[0] = *(const u32x4*)(P + (size_t)(rb_ + krow_s) * ATT_W + vcol + kch * 8); } } while (0)
#define A_LSTORE(buf, kreg, vreg) do { *(LAS u32x4*)(lds + (buf) * AK_BYTES + krow_s * AK_PITCH + kch * 16) = kreg;   \
        if (DVT == 4) { _Pragma("unroll") for (int i_ = 0; i_ < DVT / 2; ++i_) { const int idx_ = tid + 512 * i_; *(LAS u32x4*)(lds + GEO::VOFF + (buf) * GEO::VBYTES + (idx_ >> 4) * GEO::VP + (idx_ & 15) * 16) = vreg[i_]; } } \
        else { *(LAS u32x4*)(lds + GEO::VOFF + (buf) * GEO::VBYTES + krow_s * GEO::VP + kch * 16) = vreg[0]; } } while (0)
    const int q4 = (lane & 15) >> 2, p4 = lane & 3, blk = (lane >> 4) & 1;
#define A_TILE(t, cur) do { \
        f32x16 s0, s1; _Pragma("unroll") for (int r = 0; r < 16; ++r) { s0[r] = nref; s1[r] = nref; } \
        const LAS unsigned char* kb = lds + (cur) * AK_BYTES + l31 * AK_PITCH + h * 16; \
        _Pragma("unroll") for (int ks = 0; ks < 4; ++ks) { \
            const bf16x8 a0 = *(const LAS bf16x8*)(kb + ks * 32), a1 = *(const LAS bf16x8*)(kb + 32 * AK_PITCH + ks * 32); \
            s0 = MFMA32(a0, qf[ks], s0); s1 = MFMA32(a1, qf[ks], s1); } \
        float mx = fmaxf(fmaxf(s0[0], s0[1]), s1[0]); \
        _Pragma("unroll") for (int r = 2; r < 16; r += 2) mx = fmaxf(fmaxf(mx, s0[r]), s0[r + 1]); \
        _Pragma("unroll") for (int r = 1; r < 15; r += 2) mx = fmaxf(fmaxf(mx, s1[r]), s1[r + 1]); \
        mx = fmaxf(mx, s1[15]); \
        mx = swp_max(mx); \
        if ((t) == 0 || __builtin_amdgcn_ballot_w64(mx > 6.0f) != 0ull) { \
            const float dl = ((t) == 0) ? mx : fmaxf(mx, 0.f), alpha = ((t) == 0) ? 1.0f : __builtin_amdgcn_exp2f(-dl); \
            mrun += dl; lsum *= alpha; \
            _Pragma("unroll") for (int r = 0; r < 16; ++r) { s0[r] -= dl; s1[r] -= dl; } nref = -mrun; \
            _Pragma("unroll") for (int tt = 0; tt < DVT; ++tt) _Pragma("unroll") for (int r = 0; r < 16; ++r) acc[tt][r] *= alpha; } \
        float psum = 0.f; \
        _Pragma("unroll") for (int r = 0; r < 16; ++r) { s0[r] = __builtin_amdgcn_exp2f(s0[r]); s1[r] = __builtin_amdgcn_exp2f(s1[r]); psum += s0[r] + s1[r]; } \
        lsum += psum; \
        bf16x8 pf[4]; pf[0] = pack_step<0>(s0); pf[1] = pack_step<1>(s0); pf[2] = pack_step<0>(s1); pf[3] = pack_step<1>(s1); \
        const LAS unsigned char* vb = lds + GEO::VOFF + (cur) * GEO::VBYTES + (4 * h + q4) * GEO::VP + (16 * blk + 4 * p4) * 2; \
        _Pragma("unroll") for (int kk = 0; kk < 4; ++kk) { const int kbase = 32 * (kk >> 1) + 16 * (kk & 1); \
            _Pragma("unroll") for (int tt = 0; tt < DVT; ++tt) { \
                const s16x4 lo = tr_read(vb + kbase * GEO::VP + tt * 64), hi = tr_read(vb + (kbase + 8) * GEO::VP + tt * 64); \
                acc[tt] = MFMA32(cat8(lo, hi), pf[kk], acc[tt]); } } } while (0)
    A_GLOAD(0, kregA, vregA); A_LSTORE(0, kregA, vregA); A_GLOAD(1, kregA, vregA); A_LSTORE(1, kregA, vregA);
    __syncthreads();
    const int ns = nt >> 1;
    for (int sg = 0; sg < ns; ++sg) {
        const int sb = (sg & 1) * 2;
        if (sg + 1 < ns) A_GLOAD(2 * sg + 2, kregA, vregA);
        A_TILE(2 * sg, sb);
        if (sg + 1 < ns) { A_LSTORE((sb ^ 2), kregA, vregA); A_GLOAD(2 * sg + 3, kregA, vregA); }
        A_TILE(2 * sg + 1, sb + 1);
        if (sg + 1 < ns) A_LSTORE((sb ^ 2) + 1, kregA, vregA);
        __syncthreads();
    }
#undef A_TILE
    lsum = swp_sum(lsum);
#undef A_ROWBASE
#undef A_GLOAD
#undef A_LSTORE
}

DI void attn_phase(const Ctx& F, int l) {
    PHASE_IDS
    const int i2 = l >> 1; const bf16_t* P = (const bf16_t*)(F.ws + WS_BIG); bf16_t* O = (bf16_t*)(F.ws + WS_H);
    const int lane = LANE, l31 = lane & 31, h = lane >> 5;
    const float lam_init = 0.8f - 0.6f * expf(-0.3f * (float)l);
    float lam;
    { const float* lv = F.in[I_DLAM] + i2 * 256; const float a = wave_sum(lv[lane] * lv[64 + lane]), bsum = wave_sum(lv[128 + lane] * lv[192 + lane]); lam = expf(a) - expf(bsum) + lam_init; }
    constexpr int NU = 1024 + 2048 + 128 + 256;
    const int vcu = (F.G % 8 == 0) ? ((int)blockIdx.x % 8) * (F.G / 8) + (int)blockIdx.x / 8 : (int)blockIdx.x;
    for (int u = vcu; u < NU; u += F.G) {
        int b, hd, qb; bool diff, ctxq;
        if (u < 1024) { diff = true; ctxq = false; b = u >> 5; hd = (u >> 3) & 3; qb = u & 7; }
        else if (u < 3072) { const int v = u - 1024; diff = false; ctxq = false; b = v >> 6; hd = (v >> 3) & 7; qb = v & 7; }
        else if (u < 3200) { const int v = u - 3072; diff = true; ctxq = true; b = v >> 2; hd = v & 3; qb = 0; }
        else { const int v = u - 3200; diff = false; ctxq = true; b = v >> 3; hd = v & 7; qb = 0; }
        const int qrow = (ctxq ? T_LAT + b * CTXL : b * SEQ + qb * 256) + F.wave * 32 + l31;
        if (diff) {
            f32x16 a1[4], a2[4]; float l1, l2;
            attn_pass<4>(a1, l1, F, P, b, ctxq, qrow, hd * 128, 512 + hd * 128, 1024 + hd * 128, nullptr);
            attn_pass<4>(a2, l2, F, P, b, ctxq, qrow, hd * 128 + 64, 512 + hd * 128 + 64, 1024 + hd * 128, nullptr);
            const float i1 = 1.0f / l1, i2s = lam / l2; float ss = 0.f;
#pragma unroll
            for (int t = 0; t < 4; ++t)
#pragma unroll
                for (int r = 0; r < 16; ++r) { const float o = a1[t][r] * i1 - a2[t][r] * i2s; a1[t][r] = o; ss += o * o; }
            ss = swp_sum(ss);
            const float rs = rsqrtf(ss * (1.0f / 128.0f) + RMS_EPS) * (1.0f - lam_init);
            const float* sg = F.in[I_SUBLN] + i2 * 128;
            bf16_t* orow = O + (size_t)qrow * DM + hd * 128;
#pragma unroll
            for (int t = 0; t < 4; ++t)
#pragma unroll
                for (int g = 0; g < 4; ++g) { const int dv = t * 32 + 8 * g + 4 * h; const f32x4 gg = *(const f32x4*)(sg + dv);
                    u32x2 w; w.x = cvt_pk_bf16(a1[t][4 * g] * rs * gg[0], a1[t][4 * g + 1] * rs * gg[1]); w.y = cvt_pk_bf16(a1[t][4 * g + 2] * rs * gg[2], a1[t][4 * g + 3] * rs * gg[3]);
                    *(u32x2*)(orow + dv) = w; }
        } else {
            f32x16 a1[2]; float l1;
            attn_pass<2>(a1, l1, F, P, b, ctxq, qrow, 1536 + hd * 64, 2048 + (hd >> 2) * 64, 2176 + (hd >> 2) * 64, F.in[I_QKG] + (i2 * 2 + 0) * 64);
            const float i1 = 1.0f / l1;
            bf16_t* orow = O + (size_t)qrow * DM + 512 + hd * 64;
#pragma unroll
            for (int t = 0; t < 2; ++t)
#pragma unroll
                for (int g = 0; g < 4; ++g) { const int dv = t * 32 + 8 * g + 4 * h;
                    u32x2 w; w.x = cvt_pk_bf16(a1[t][4 * g] * i1, a1[t][4 * g + 1] * i1); w.y = cvt_pk_bf16(a1[t][4 * g + 2] * i1, a1[t][4 * g + 3] * i1);
                    *(u32x2*)(orow + dv) = w; }
        }
    }
}
constexpr int GP = 272;
constexpr int GU_Q = 0, GU_K = 64 * GP, GU_V = 2 * 64 * GP, GU_M = 3 * 64 * GP, GU_ATT = 4 * 64 * GP, GU_SC = GU_ATT + 6144, GU_M10 = GU_SC + 1024, GU_BYTES = 80896;
DI f32x16 tile_nt(const LAS unsigned char* A, const LAS unsigned char* B, int l31, int h) {
    f32x16 c;
#pragma unroll
    for (int r = 0; r < 16; ++r) c[r] = 0.f;
    const LAS unsigned char* ap = A + l31 * GP + h * 16; const LAS unsigned char* bp = B + l31 * GP + h * 16;
#pragma unroll
    for (int ks = 0; ks < 8; ++ks) c = MFMA32(*(const LAS bf16x8*)(ap + ks * 32), *(const LAS bf16x8*)(bp + ks * 32), c);
    return c;
}
DI float softplus_f(float x) { const float e = __expf(x); const float sm = e * (1.0f - e * (0.5f - e * 0.33333334f)); return x > 20.f ? x : (e < 0.01f ? sm : __logf(1.0f + e)); }

DI void gdn_scan_phase(const Ctx& F, int l) {
    const int i2 = l >> 1;
    const bf16_t* P = (const bf16_t*)(F.ws + WS_BIG);
    const float* convw = F.in[I_GCONV] + (size_t)i2 * 4 * 3072;
    const int w4 = F.wave & 3, ub = F.wave >> 2;
    const int e0 = 32 * w4;
    for (int u0 = 2 * blockIdx.x; u0 < 512; u0 += 2 * F.G) {
        const int u = u0 + ub, b = u >> 4, hd = (u >> 1) & 7, dir = u & 1;
        bf16_t* Od = (bf16_t*)(F.ws + (dir ? WS_Y : WS_H));
        const float nalog = __uint_as_float(__builtin_amdgcn_readfirstlane(__float_as_uint(-__expf(F.in[I_GALOG][i2 * 16 + dir * 8 + hd])))), dtb = __uint_as_float(__builtin_amdgcn_readfirstlane(__float_as_uint(F.in[I_GDT][i2 * 16 + dir * 8 + hd])));
        f32x16 S[4];
#pragma unroll
        for (int t = 0; t < 4; ++t)
#pragma unroll
            for (int r = 0; r < 16; ++r) S[t][r] = 0.f;
        for (int step = 0; step < 36; ++step) {
            const bool isctx = step < 4; const int cidx = dir ? (isctx ? 3 - step : 35 - step) : (isctx ? step : step - 4);
            const int seq0 = isctx ? T_LAT + b * CTXL : b * SEQ, L = isctx ? CTXL : SEQ, t0 = 64 * cidx;
            const int lane = get_lane(); const int ut = (F.wave & 3) * 64 + lane;
            const int l31 = lane & 31, h = lane >> 5, q4 = (lane & 15) >> 2, p4 = lane & 3, blk = (lane >> 4) & 1;
            int zs; asm volatile("s_mov_b32 %0, 0" : "=s"(zs));
            LAS unsigned char* U = F.lds + ub * GU_BYTES + zs;
            LAS float* SC = (LAS float*)(U + GU_SC);
            const LAS float* SCh = SC + 4 * h + zs;
#ifndef GDN_NOSTAGE
            unsigned pf0 = 0u, pf1 = 0u;
            {
                const int seg = ut >> 4, cg8 = ut & 15;
                const float* cwl = convw + zs;
                const bf16_t* pbase = P + (size_t)seq0 * GDN_W + hd * 128 + cg8 * 8;
                u32x4 rawA[7], rawB[7];
#define GS_LOAD(raw, MAT) do { _Pragma("unroll") for (int rr = 0; rr < 7; ++rr) { const int ts = t0 + 4 * seg - 2 + rr; u32x4 w_ = {0u, 0u, 0u, 0u}; \
                    if (ts >= 0 && ts < L) w_ = *(const u32x4*)(pbase + (size_t)ts * GDN_W + (MAT) * 1024); raw[rr] = w_; } } while (0)
#define GS_PROC(raw, MAT) do { const int col0 = (MAT) * 1024 + hd * 128 + cg8 * 8; float o[4][8]; \
                    _Pragma("unroll") for (int a = 0; a < 4; ++a) _Pragma("unroll") for (int c = 0; c < 8; ++c) o[a][c] = 0.f; \
                    _Pragma("unroll") for (int j = 0; j < 4; ++j) { const f32x4 wa = *(const f32x4*)(cwl + j * 3072 + col0), wb = *(const f32x4*)(cwl + j * 3072 + col0 + 4); \
                        _Pragma("unroll") for (int a = 0; a < 4; ++a) { const u32x4 w_ = raw[a + j]; \
                            o[a][0] += wa[0] * bflo(w_.x); o[a][1] += wa[1] * bfhi(w_.x); o[a][2] += wa[2] * bflo(w_.y); o[a][3] += wa[3] * bfhi(w_.y); \
                            o[a][4] += wb[0] * bflo(w_.z); o[a][5] += wb[1] * bfhi(w_.z); o[a][6] += wb[2] * bflo(w_.w); o[a][7] += wb[3] * bfhi(w_.w); } } \
                    _Pragma("unroll") for (int a = 0; a < 4; ++a) { float ss = 0.f; \
                        _Pragma("unroll") for (int c = 0; c < 8; ++c) { o[a][c] = silu_f(o[a][c]); ss += o[a][c] * o[a][c]; } \
                        float sc = 1.0f; \
                        if ((MAT) < 2) { ss += shx<1>(ss); ss += shx<2>(ss); ss += shx<4>(ss); ss += shx<8>(ss); sc = rsqrtf(ss + 1e-6f) * ((MAT) == 0 ? 0.08838834764831845f : 1.0f); } \
                        const int tk = 4 * seg + a, row = dir ? 63 - tk : tk; \
                        u32x4 w; w.x = cvt_pk_bf16(o[a][0] * sc, o[a][1] * sc); w.y = cvt_pk_bf16(o[a][2] * sc, o[a][3] * sc); w.z = cvt_pk_bf16(o[a][4] * sc, o[a][5] * sc); w.w = cvt_pk_bf16(o[a][6] * sc, o[a][7] * sc); \
                        *(LAS u32x4*)(U + (MAT) * 64 * GP + row * GP + cg8 * 16) = w; } } while (0)
                bf16_t av_r = 0, bv_r = 0;
                if (w4 == 0) { const int tk = dir ? 63 - lane : lane; const bf16_t* prow = P + (size_t)(seq0 + t0 + tk) * GDN_W + 4096 + dir * 8 + hd; av_r = prow[0]; bv_r = prow[16]; }
                GS_LOAD(rawA, 0); GS_LOAD(rawB, 1);
                GS_PROC(rawA, 0);
                GS_LOAD(rawA, 2);
                GS_PROC(rawB, 1);
                GS_PROC(rawA, 2);
#undef GS_LOAD
#undef GS_PROC
                if (w4 == 0) {
                    const float av = bf2f(av_r), bv = bf2f(bv_r);
                    float g = nalog * softplus_f(av + dtb);
#pragma unroll
                    for (int off = 1; off < 64; off <<= 1) { const float t_ = __int_as_float(__builtin_amdgcn_ds_bpermute((lane - off) << 2, __float_as_int(g))); if (lane >= off) g += t_; }
                    const float glast = __int_as_float(__builtin_amdgcn_readlane(__float_as_int(g), 63));
                    SC[lane] = g; SC[64 + lane] = 1.0f / (1.0f + __expf(-bv)); SC[128 + lane] = __expf(g); SC[192 + lane] = __expf(glast - g);
                }
                if (step + 1 < 36) {
                    const int st1 = step + 1; const bool ic1 = st1 < 4; const int ci1 = dir ? (ic1 ? 3 - st1 : 35 - st1) : (ic1 ? st1 : st1 - 4);
                    const int sq1 = ic1 ? T_LAT + b * CTXL : b * SEQ, L1 = ic1 ? CTXL : SEQ, t1 = 64 * ci1;
                    const int li0 = ut, li1 = ut + 256;
                    { const int row = li0 / 6, part = li0 % 6, ts = t1 - 2 + row; if (ts >= 0 && ts < L1) pf0 = *(const unsigned*)(P + (size_t)(sq1 + ts) * GDN_W + (part >> 1) * 1024 + hd * 128 + (part & 1) * 64); }
                    if (li1 < 402) { const int row = li1 / 6, part = li1 % 6, ts = t1 - 2 + row; if (ts >= 0 && ts < L1) pf1 = *(const unsigned*)(P + (size_t)(sq1 + ts) * GDN_W + (part >> 1) * 1024 + hd * 128 + (part & 1) * 64); }
                }
            }
#endif
            __syncthreads();
#ifndef GDN_NOTILES
            {
                const LAS unsigned char* Qm = U + GU_Q; const LAS unsigned char* Km = U + GU_K;
                if (w4 < 3) {
                    const int jt = (w4 == 2) ? 1 : 0, it = (w4 == 0) ? 0 : 1;
                    f32x16 c = tile_nt(Km + 32 * jt * GP, Qm + 32 * it * GP, l31, h);
                    const int i = 32 * it + l31; const float gi = SC[i]; const int im = i - 4 * h + zs - 32 * jt;
#pragma unroll
                    for (int r = 0; r < 16; ++r) { const int c0 = (r & 3) + 8 * (r >> 2); const float ar = fminf(gi - SCh[32 * jt + c0], 0.f); c[r] = (c0 <= im) ? c[r] * __expf(ar) : 0.f; }
                    *(LAS bf16x8*)(U + GU_ATT + ((w4 * 2 + 0) * 64 + lane) * 16) = pack_step<0>(c);
                    *(LAS bf16x8*)(U + GU_ATT + ((w4 * 2 + 1) * 64 + lane) * 16) = pack_step<1>(c);
                }
                if (w4 == 0) {
                    f32x16 c = tile_nt(Km, Km + 32 * GP, l31, h);
                    const int i = 32 + l31; const float gi = SC[i], bi = SC[64 + i];
#pragma unroll
                    for (int r = 0; r < 16; ++r) { const int c0 = (r & 3) + 8 * (r >> 2); const float ar = fminf(gi - SCh[c0], 0.f); c[r] = bi * c[r] * __expf(ar); }
                    *(LAS bf16x8*)(U + GU_M10 + (0 * 64 + lane) * 16) = pack_step<0>(c);
                    *(LAS bf16x8*)(U + GU_M10 + (1 * 64 + lane) * 16) = pack_step<1>(c);
                }
                if (w4 == 1 || w4 == 3) {
                    const int ti = (w4 == 3) ? 0 : 1, tj = ti;
                    f32x16 c = tile_nt(Km + 32 * ti * GP, Km + 32 * tj * GP, l31, h);
                    const int j = 32 * tj + l31; const float gj = SC[j]; const int jm = j - 4 * h + zs - 32 * ti;
                    LAS unsigned char* mb = U + GU_M + (32 * ti + 4 * h) * GP + j * 4 + zs;
#pragma unroll
                    for (int r = 0; r < 16; ++r) { const int c0 = (r & 3) + 8 * (r >> 2); const float ar = fminf(SCh[32 * ti + c0] - gj, 0.f); const float mv = (c0 > jm) ? SCh[64 + 32 * ti + c0] * c[r] * __expf(ar) : 0.f;
                        *(LAS float*)(mb + c0 * GP) = mv; }
                    { const int i = 32 * ti + l31; const float gi = SC[i], bi = SC[64 + i]; f32x16 cc;
#pragma unroll
                      for (int r = 0; r < 16; ++r) { const int c0 = (r & 3) + 8 * (r >> 2); const float ar = fminf(gi - SCh[32 * ti + c0], 0.f); cc[r] = (r < 8 && l31 >= 16) ? bi * c[r] * __expf(ar) : 0.f; }
                      *(LAS bf16x8*)(U + GU_M10 + ((2 + ti) * 64 + lane) * 16) = pack_step<0>(cc); }
                }
            }
#endif
            __syncthreads();
            __builtin_amdgcn_sched_barrier(0);
            f32x16 R[2];
#pragma unroll
            for (int t = 0; t < 2; ++t)
#pragma unroll
                for (int r = 0; r < 16; ++r) R[t][r] = 0.f;
#define GD_KS(DT, SS) do { const bf16x8 sf = pack_step<SS>(S[DT]); const int dcol = (32 * (DT) + 16 * (SS) + 4 * h) * 2; \
                _Pragma("unroll") for (int it = 0; it < 2; ++it) { const LAS unsigned char* rp = U + (32 * it + l31) * GP + dcol; \
                    const bf16x8 ak = cat8(*(const LAS s16x4*)(rp + GU_K), *(const LAS s16x4*)(rp + GU_K + 16)); \
                    R[it] = MFMA32(ak, sf, R[it]); } } while (0)
            GD_KS(0, 0); GD_KS(0, 1); GD_KS(1, 0); GD_KS(1, 1); GD_KS(2, 0); GD_KS(2, 1); GD_KS(3, 0); GD_KS(3, 1);
#undef GD_KS
            __builtin_amdgcn_sched_barrier(0);
            f32x16 X[2];
#pragma unroll
            for (int t = 0; t < 2; ++t)
#pragma unroll
                for (int r = 0; r < 16; ++r) { const int c0 = 32 * t + (r & 3) + 8 * (r >> 2); const float vv = bf2f(*(const LAS bf16_t*)(U + GU_V + 4 * h * GP + (e0 + l31) * 2 + zs + c0 * GP)); const float eg = SCh[128 + c0];
                    X[t][r] = SCh[64 + c0] * (vv - eg * R[t][r]); }
#ifndef GDN_NOSTAGE
            asm volatile("" :: "v"(pf0), "v"(pf1));
#endif
            asm volatile("" : "+v"(X[0]), "+v"(X[1]));
            __builtin_amdgcn_sched_barrier(0);
#ifndef GDN_NOSOLVE
            {
                const LAS unsigned char* Mh = U + GU_M + 4 * h * GP;
                float xs[2][16];
#pragma unroll
                for (int t_ = 0; t_ < 2; ++t_)
#pragma unroll
                    for (int r_ = 0; r_ < 16; ++r_) xs[t_][r_] = X[t_][r_];
                int zdep = 0;
#pragma unroll
                for (int G = 0; G < 16; ++G) {
                    const int t = G >> 3, rb = 4 * ((G >> 1) & 3), hG = G & 1, i0 = 4 * G;
                    {
                        const bool own = (h == hG);
                        const LAS unsigned char* mp = U + GU_M + i0 * GP + i0 * 4 + zdep;
                        const float m10 = *(const LAS float*)(mp + GP); const f32x2 m2 = *(const LAS f32x2*)(mp + 2 * GP); const f32x4 m3 = *(const LAS f32x4*)(mp + 3 * GP);
                        const float n1 = xs[t][rb + 1] - m10 * xs[t][rb]; xs[t][rb + 1] = own ? n1 : xs[t][rb + 1];
                        const float n2 = xs[t][rb + 2] - (m2[0] * xs[t][rb] + m2[1] * xs[t][rb + 1]); xs[t][rb + 2] = own ? n2 : xs[t][rb + 2];
                        const float n3 = xs[t][rb + 3] - (m3[0] * xs[t][rb] + m3[1] * xs[t][rb + 1] + m3[2] * xs[t][rb + 2]); xs[t][rb + 3] = own ? n3 : xs[t][rb + 3];
                    }
                    __builtin_amdgcn_sched_barrier(0);
                    float v0 = xs[t][rb], v1 = xs[t][rb + 1], v2 = xs[t][rb + 2], v3 = xs[t][rb + 3];
                    const float o0 = swp_other(v0, h), o1 = swp_other(v1, h), o2 = swp_other(v2, h), o3 = swp_other(v3, h);
                    v0 = (h != hG) ? o0 : v0; v1 = (h != hG) ? o1 : v1; v2 = (h != hG) ? o2 : v2; v3 = (h != hG) ? o3 : v3;
                    asm volatile("v_and_b32 %0, 0, %1" : "=v"(zdep) : "v"(v3));
#pragma unroll
                    for (int tt = 0; tt < 2; ++tt)
#pragma unroll
                        for (int rg = 0; rg < 4; ++rg) {
                            const int Gb = 8 * tt + 2 * rg;
                            if (Gb >= G && ((Gb >> 2) == (G >> 2))) {
                                const LAS unsigned char* Mz = Mh + zdep;
                                const bool upd = (Gb > G) || (h == 1);
#pragma unroll
                                for (int a = 0; a < 4; ++a) { const f32x4 mm = *(const LAS f32x4*)(Mz + (32 * tt + 8 * rg + a) * GP + i0 * 4);
                                    const float nv = xs[tt][4 * rg + a] - ((mm[0] * v0 + mm[1] * v1) + (mm[2] * v2 + mm[3] * v3)); xs[tt][4 * rg + a] = upd ? nv : xs[tt][4 * rg + a]; }
                                if (rg == 3) asm volatile("v_and_b32 %0, 0, %1" : "=v"(zdep) : "v"(xs[tt][15]), "v"(xs[tt][14]), "v"(xs[tt][13]), "v"(xs[tt][12]), "v"(xs[tt][11]), "v"(xs[tt][10]), "v"(xs[tt][9]), "v"(xs[tt][8]), "v"(xs[tt][7]), "v"(xs[tt][6]), "v"(xs[tt][5]), "v"(xs[tt][4]), "v"(xs[tt][3]), "v"(xs[tt][2]), "v"(xs[tt][1]), "v"(xs[tt][0]));
                            }
                        }
                    if (G == 3 || G == 11) {
                        const int tq = G >> 3; f32x16 xb, ab;
#pragma unroll
                        for (int r_ = 0; r_ < 16; ++r_) { xb[r_] = xs[tq][r_]; ab[r_] = 0.f; }
                        ab = MFMA32(*(const LAS bf16x8*)(U + GU_M10 + (2 + tq) * 1024 + lane * 16 + zdep), pack_step<0>(xb), ab);
#pragma unroll
                        for (int r_ = 0; r_ < 16; ++r_) xs[tq][r_] -= ab[r_];
                    }
                    if (G == 7) {
                        f32x16 x0, a10;
#pragma unroll
                        for (int r_ = 0; r_ < 16; ++r_) { x0[r_] = xs[0][r_]; a10[r_] = 0.f; }
                        const LAS unsigned char* mf = U + GU_M10 + lane * 16 + zdep;
                        a10 = MFMA32(*(const LAS bf16x8*)(mf), pack_step<0>(x0), a10);
                        a10 = MFMA32(*(const LAS bf16x8*)(mf + 1024), pack_step<1>(x0), a10);
#pragma unroll
                        for (int r_ = 0; r_ < 16; ++r_) xs[1][r_] -= a10[r_];
                    }
                }
#pragma unroll
                for (int t_ = 0; t_ < 2; ++t_)
#pragma unroll
                    for (int r_ = 0; r_ < 16; ++r_) X[t_][r_] = xs[t_][r_];
            }
#endif
            __builtin_amdgcn_sched_barrier(0);
#ifndef GDN_NOPOST
            if (!(l == 3 && isctx)) {
                int zs2; asm volatile("v_and_b32 %0, 0, %1" : "=v"(zs2) : "v"(X[1][15]));
                const LAS float* SCh2 = (const LAS float*)((const LAS unsigned char*)(SC + 4 * h) + zs2);
                const LAS unsigned char* U2 = U + zs2;
                asm volatile("" : "+v"(S[0]), "+v"(S[1]), "+v"(S[2]), "+v"(S[3]));
                f32x16 Oq[2];
#pragma unroll
                for (int t = 0; t < 2; ++t)
#pragma unroll
                    for (int r = 0; r < 16; ++r) Oq[t][r] = 0.f;
#define GD_QS(DT, SS) do { const bf16x8 sf = pack_step<SS>(S[DT]); const int dcol = (32 * (DT) + 16 * (SS) + 4 * h) * 2; \
                _Pragma("unroll") for (int it = 0; it < 2; ++it) { const LAS unsigned char* rp = U2 + (32 * it + l31) * GP + dcol; \
                    const bf16x8 aq = cat8(*(const LAS s16x4*)(rp + GU_Q), *(const LAS s16x4*)(rp + GU_Q + 16)); \
                    Oq[it] = MFMA32(aq, sf, Oq[it]); } } while (0)
                GD_QS(0, 0); GD_QS(0, 1); GD_QS(1, 0); GD_QS(1, 1); GD_QS(2, 0); GD_QS(2, 1); GD_QS(3, 0); GD_QS(3, 1);
#undef GD_QS
#pragma unroll
                for (int t = 0; t < 2; ++t)
#pragma unroll
                    for (int r = 0; r < 16; ++r) Oq[t][r] *= SCh2[128 + 32 * t + (r & 3) + 8 * (r >> 2)];
                const bf16x8 vf0 = pack_step<0>(X[0]), vf1 = pack_step<1>(X[0]), vf2 = pack_step<0>(X[1]), vf3 = pack_step<1>(X[1]);
                const LAS unsigned char* at = U2 + GU_ATT + lane * 16;
                Oq[0] = MFMA32(*(const LAS bf16x8*)(at + 0 * 1024), vf0, Oq[0]); Oq[0] = MFMA32(*(const LAS bf16x8*)(at + 1 * 1024), vf1, Oq[0]);
                Oq[1] = MFMA32(*(const LAS bf16x8*)(at + 2 * 1024), vf0, Oq[1]); Oq[1] = MFMA32(*(const LAS bf16x8*)(at + 3 * 1024), vf1, Oq[1]);
                Oq[1] = MFMA32(*(const LAS bf16x8*)(at + 4 * 1024), vf2, Oq[1]); Oq[1] = MFMA32(*(const LAS bf16x8*)(at + 5 * 1024), vf3, Oq[1]);
                const int sdm = dir ? -DM : DM;
                bf16_t* ob = Od + (size_t)(seq0 + t0 + (dir ? 63 - 4 * h : 4 * h)) * DM + hd * 128 + e0 + l31;
#pragma unroll
                for (int t = 0; t < 2; ++t)
#pragma unroll
                    for (int rg = 0; rg < 4; ++rg) { bf16_t* pg = ob + (32 * t + 8 * rg) * sdm;
#pragma unroll
                        for (int a = 0; a < 4; ++a) __builtin_nontemporal_store(f2bf(Oq[t][4 * rg + a]), pg + a * sdm); }
            }
            __builtin_amdgcn_sched_barrier(0);
            {
                int zs3; asm volatile("v_and_b32 %0, 0, %1" : "=v"(zs3) : "v"(X[0][0]));
                const LAS float* SCh3 = (const LAS float*)((const LAS unsigned char*)(SC + 4 * h) + zs3);
                const float gl = SC[128 + 63];
#pragma unroll
                for (int t = 0; t < 4; ++t)
#pragma unroll
                    for (int r = 0; r < 16; ++r) S[t][r] *= gl;
#pragma unroll
                for (int t = 0; t < 2; ++t)
#pragma unroll
                    for (int r = 0; r < 16; ++r) X[t][r] *= SCh3[192 + 32 * t + (r & 3) + 8 * (r >> 2)];
                const bf16x8 vf[4] = {pack_step<0>(X[0]), pack_step<1>(X[0]), pack_step<0>(X[1]), pack_step<1>(X[1])};
                const LAS unsigned char* kt = U + GU_K + (4 * h + q4) * GP + (16 * blk + 4 * p4) * 2 + zs3;
#pragma unroll
                for (int jk = 0; jk < 4; ++jk) {
                    const int ib = 32 * (jk >> 1) + 16 * (jk & 1);
#pragma unroll
                    for (int dt = 0; dt < 4; ++dt) { const s16x4 lo = tr_read(kt + ib * GP + dt * 64), hi = tr_read(kt + (ib + 8) * GP + dt * 64); S[dt] = MFMA32(cat8(lo, hi), vf[jk], S[dt]); }
                }
            }
#else
            S[0][0] += X[0][0] + X[1][15]; S[1][3] += X[0][7];
#endif
            __syncthreads();
        }
    }
}

DI void gdn_readout_phase(const Ctx& F, int l, int Mrows) {
    PHASE_IDS
    const int i2 = l >> 1; const bf16_t* P = (const bf16_t*)(F.ws + WS_BIG); bf16_t* Of = (bf16_t*)(F.ws + WS_H); const bf16_t* Ob = (const bf16_t*)(F.ws + WS_Y);
    const f32x4 gg = *(const f32x4*)(F.in[I_GNORM] + i2 * 128 + ((4 * LANE) & 127));
    const int rpw = (Mrows + F.ngw - 1) / F.ngw, mb = F.gw * rpw, me = (mb + rpw < Mrows) ? mb + rpw : Mrows;
    if (mb >= me) return;
    u32x2 an[4], bn[4], zn[4];
#define RO_FETCH(m_) do { const u32x2* ofp_ = (const u32x2*)(Of + (size_t)(m_) * DM) + LANE; const u32x2* obp_ = (const u32x2*)(Ob + (size_t)(m_) * DM) + LANE; const u32x2* zp_ = (const u32x2*)(P + (size_t)(m_) * GDN_W + 3072) + LANE; \
        _Pragma("unroll") for (int j = 0; j < 4; ++j) { an[j] = __builtin_nontemporal_load(ofp_ + 64 * j); bn[j] = __builtin_nontemporal_load(obp_ + 64 * j); zn[j] = __builtin_nontemporal_load(zp_ + 64 * j); } } while (0)
    RO_FETCH(mb);
    for (int m = mb; m < me; ++m) {
        u32x2 av[4], bv[4], zv[4];
#pragma unroll
        for (int j = 0; j < 4; ++j) { av[j] = an[j]; bv[j] = bn[j]; zv[j] = zn[j]; }
        if (m + 1 < me) RO_FETCH(m + 1);
        u32x2* ofp = (u32x2*)(Of + (size_t)m * DM) + LANE;
#pragma unroll
        for (int j = 0; j < 4; ++j) {
            const u32x2 a = av[j], bq = bv[j], z = zv[j];
            f32x4 o = (f32x4){bflo(a.x) + bflo(bq.x), bfhi(a.x) + bfhi(bq.x), bflo(a.y) + bflo(bq.y), bfhi(a.y) + bfhi(bq.y)};
            float ss = (o[0] * o[0] + o[1] * o[1]) + (o[2] * o[2] + o[3] * o[3]);
            ss += shx<1>(ss); ss += shx<2>(ss); ss += shx<4>(ss); ss += shx<8>(ss); ss += shx<16>(ss);
            const float rs = rsqrtf(ss * (1.0f / 128.0f) + RMS_EPS);
            const f32x4 zz = (f32x4){bflo(z.x), bfhi(z.x), bflo(z.y), bfhi(z.y)};
            u32x2 w; w.x = cvt_pk_bf16(o[0] * rs * gg[0] * silu_f(zz[0]), o[1] * rs * gg[1] * silu_f(zz[1])); w.y = cvt_pk_bf16(o[2] * rs * gg[2] * silu_f(zz[2]), o[3] * rs * gg[3] * silu_f(zz[3]));
            ofp[64 * j] = w;
        }
    }
#undef RO_FETCH
}
#define XB_TMO      128
#define XB_XCNT(j)  (256  + 64 * (j))
#define XB_XSUB(j)  (1280 + 64 * (j))
#define XB_XGEN(j)  (2304 + 64 * (j))
#define XB_TOP      3328
#define XB_TOPGEN   3392
#define XCD_BAR_WORDS 3456
#define XB_SPIN_CAP (1u << 24)

__device__ __forceinline__ unsigned xb_ld(unsigned* p)              { return __hip_atomic_load(p, __ATOMIC_RELAXED, __HIP_MEMORY_SCOPE_AGENT); }
__device__ __forceinline__ unsigned xb_add(unsigned* p, unsigned v) { return __hip_atomic_fetch_add(p, v, __ATOMIC_RELAXED, __HIP_MEMORY_SCOPE_AGENT); }
__device__ __forceinline__ unsigned xb_xcc_id() { return (unsigned)__builtin_amdgcn_s_getreg((3 << 11) | 20) & 0xFu; }
#define XB_SPIN(cond, bar) do { unsigned _sp = 0; while (cond) { __builtin_amdgcn_s_sleep(1); \
    if ((++_sp & 255u) == 0u) { if (xb_ld(&(bar)[XB_TMO])) break; if (_sp > XB_SPIN_CAP) { atomicAdd(&(bar)[XB_TMO], 1u); break; } } } } while (0)

struct XcdBarrier {
    unsigned* bar; unsigned x;
    volatile LAS unsigned* st;
};

__device__ __forceinline__ XcdBarrier xcd_barrier_post(unsigned* bar, volatile LAS unsigned* st) {
    XcdBarrier b; b.bar = bar; b.x = xb_xcc_id(); b.st = st;
    if (threadIdx.x == 0) (void)xb_add(&bar[XB_XCNT(b.x)], 1u);
    return b;
}
__device__ __forceinline__ void xcd_barrier_complete(unsigned* bar, unsigned x, unsigned& nloc, unsigned& nx) {
    const unsigned G = gridDim.x * gridDim.y * gridDim.z;
    unsigned sum, cnt, mine, sp = 0u;
    for (;;) {
        sum = 0u; cnt = 0u; mine = 0u;
#pragma unroll
        for (unsigned j = 0; j < 16; ++j) { const unsigned c = xb_ld(&bar[XB_XCNT(j)]); sum += c; cnt += (c > 0u) ? 1u : 0u; mine = (j == x) ? c : mine; }
        if (sum == G) break;
        __builtin_amdgcn_s_sleep(1);
        if ((++sp & 255u) == 0u) { if (xb_ld(&bar[XB_TMO])) break; if (sp > XB_SPIN_CAP) { atomicAdd(&bar[XB_TMO], 1u); break; } }
    }
    nloc = mine > 0u ? mine : 1u; nx = cnt > 0u ? cnt : 1u;
}

__device__ __forceinline__ void xcd_barrier(const XcdBarrier& b) {
    asm volatile("s_waitcnt vmcnt(0)" ::: "memory");
    __syncthreads();
    if (threadIdx.x == 0) {
        unsigned* bar = b.bar;
        __builtin_amdgcn_s_waitcnt(0);
        unsigned nloc = b.st[0], nx = b.st[1];
        if (nloc == 0u) { xcd_barrier_complete(bar, b.x, nloc, nx); b.st[0] = nloc; b.st[1] = nx; }
        const unsigned old = xb_add(&bar[XB_XSUB(b.x)], 1u);
        const unsigned gen = old / nloc;
        if (old + 1u == (gen + 1u) * nloc) {
            __builtin_amdgcn_fence(__ATOMIC_RELEASE, "agent");
            asm volatile("s_waitcnt vmcnt(0)" ::: "memory");
            const unsigned og = xb_add(&bar[XB_TOP], 1u);
            const unsigned tg = og / nx;
            if (og + 1u == (tg + 1u) * nx) xb_add(&bar[XB_TOPGEN], 1u);
            else XB_SPIN(xb_ld(&bar[XB_TOPGEN]) == tg, bar);
            __builtin_amdgcn_fence(__ATOMIC_ACQUIRE, "agent");
            xb_add(&bar[XB_XGEN(b.x)], 1u);
            asm volatile("s_waitcnt vmcnt(0)" ::: "memory");
        } else {
            XB_SPIN(xb_ld(&bar[XB_XGEN(b.x)]) == gen, bar);
            __builtin_amdgcn_fence(__ATOMIC_ACQUIRE, "agent");
            asm volatile("s_waitcnt vmcnt(0)" ::: "memory");
        }
    }
    __syncthreads();
}

template <class Epi> DI void run_gemm(const Ctx& F, const bf16_t* A, const bf16_t* Bt, int M, int N, int K, const Epi& E) {
    pg8::Gemm g{A, Bt, M, N, K}; pg8::StaticOrder S; S.init(M, N, F.G, (int)blockIdx.x);
    pg8::gemm_phase<Epi, pg8::StaticOrder, Epi::ALIGN, true>(F.lds, g, S, E, F.wave);
}
constexpr int N_PHASES = 2 + 8 * 4;
#ifndef ENMASK
#define ENMASK 0xff
#endif
#define EN(k) (((ENMASK) >> (k)) & 1)
#ifndef PROBE_DUP
#define PROBE_DUP 0
#endif
#define DUP(k) ((((PROBE_DUP) >> (k)) & 1) ? 2 : 1)
__global__ void __launch_bounds__(NTHREADS, 2) mk_fwd(Args args) {
    extern __shared__ __attribute__((aligned(16))) unsigned char lds_raw[];
    cg::grid_group grid = cg::this_grid();
    volatile LAS unsigned* bar_st = (volatile LAS unsigned*)((LAS unsigned char*)lds_raw + LDS_BYTES - 16);
    if (threadIdx.x == 0) { bar_st[0] = 0u; bar_st[1] = 0u; }
    __syncthreads();
    XcdBarrier xbar = xcd_barrier_post((unsigned*)(args.ws + WS_BAR), bar_st);
    Ctx F;
    F.in = (const float* const __attribute__((address_space(4)))*)__builtin_amdgcn_kernarg_segment_ptr();
    F.out = args.out; F.ws = args.ws; F.lds = (LAS unsigned char*)lds_raw;
    const int wave0 = __builtin_amdgcn_readfirstlane((int)threadIdx.x >> 6);
    F.wave = 0; F.gw = 0; F.G = gridDim.x; F.ngw = F.G * NWAVES;
    bf16_t *H, *Y, *BIG; const bf16_t *win_t, *wout_t, *wgu_t, *wdn_t;
    for (int ph = args.ph_lo; ph < args.ph_hi; ++ph) {
        {
            unsigned char* ws_o = args.ws; float* out_o = args.out; int wv_o = wave0; asm volatile("" : "+s"(ws_o), "+s"(out_o), "+s"(wv_o));
            F.wave = wv_o; F.gw = blockIdx.x * NWAVES + F.wave; F.ws = ws_o; F.out = out_o;
            H = (bf16_t*)(F.ws + WS_H); Y = (bf16_t*)(F.ws + WS_Y); BIG = (bf16_t*)(F.ws + WS_BIG);
            win_t = (const bf16_t*)(F.ws + WS_WIN); wout_t = (const bf16_t*)(F.ws + WS_WOUT); wgu_t = (const bf16_t*)(F.ws + WS_WGU); wdn_t = (const bf16_t*)(F.ws + WS_WDN);
        }
        if (ph == 0) { for (int rep = 0; rep < DUP(3); ++rep) { if (EN(0)) modvec_phase(F); if (EN(1)) wconv_layer(F, 0); if (rep + 1 < DUP(3)) grid.sync(); } }
        else if (ph == 1) { for (int rep = 0; rep < DUP(4); ++rep) { if (EN(2)) rowwise_phase(F, 0, 0, T_ALL); if (rep + 1 < DUP(4)) grid.sync(); } }
        else {
            const int l = (ph - 2) >> 3, sub = (ph - 2) & 7; const bool odd = l & 1; const int Mr = (l == 3) ? T_LAT : T_ALL;
            int gk = 0, gM = 0, gN = 0, gK = 0, gld = 0; const bf16_t* gA = nullptr; const bf16_t* gB = nullptr; bf16_t* gO = nullptr;
            switch (sub) {
            case 0: gk = 1; gA = H; gB = win_t; gO = BIG; gM = T_ALL; gN = odd ? GDN_W : ATT_W; gK = DM; gld = gN; break;
            case 1: if (odd) { if (EN(6)) for (int rep = 0; rep < DUP(2); ++rep) { gdn_scan_phase(F, l); if (rep + 1 < DUP(2)) grid.sync(); } } else { if (EN(4)) attn_prep_phase(F, l >> 1); } break;
            case 2: if (odd) { if (EN(7)) gdn_readout_phase(F, l, Mr); } else { if (EN(5)) for (int rep = 0; rep < DUP(1); ++rep) { attn_phase(F, l); if (rep + 1 < DUP(1)) grid.sync(); } } break;
            case 3: gk = 1; gA = H; gB = wout_t; gO = Y; gM = Mr; gN = DM; gK = DM; gld = DM; break;
            case 4: if (EN(2)) rowwise_phase(F, 1, l, Mr); break;
            case 5: gk = 2; gA = H; gB = wgu_t; gO = BIG; gM = Mr; gN = 2 * FFH; gK = DM; gld = FFH; break;
            case 6: gk = 1; gA = BIG; gB = wdn_t; gO = Y; gM = Mr; gN = DM; gK = FFH; gld = DM; break;
            default: if (EN(2)) rowwise_phase(F, 2, l, Mr); if (EN(1) && l < 3) wconv_layer(F, l + 1); break;
            }
            if (EN(3)) for (int rep = 0; rep < DUP(0); ++rep) {
                if (gk == 1) { pg8::EpiStore E{gO, gld, (sub == 0 && !odd) ? 1 : 0}; run_gemm(F, gA, gB, gM, gN, gK, E); }
                else if (gk == 2) { pg8::EpiSwiglu E{gO, gld}; run_gemm(F, gA, gB, gM, gN, gK, E); }
                if (rep + 1 < DUP(0)) grid.sync();
            }
        }
        if (ph + 1 < args.ph_hi) { if (ph == args.ph_lo) grid.sync(); else xcd_barrier(xbar); if (DUP(5) == 2) xcd_barrier(xbar); }
    }
}

extern "C" void kernel_launch(void* const* d_in, const int* in_sizes, int n_in, void* d_out, int out_size, void* d_ws, size_t ws_size, hipStream_t stream) {
    static int grid = 0;
    if (grid == 0) {
        if (n_in != 20 || out_size != T_LAT * DM || ws_size < WS_END) { fprintf(stderr, "kernel_launch: unexpected problem shape (n_in %d out %d ws %zu)\n", n_in, out_size, ws_size); grid = -1; return; }
        int dev = 0, cus = 0, per_cu = 0;
        (void)hipGetDevice(&dev); (void)hipDeviceGetAttribute(&cus, hipDeviceAttributeMultiprocessorCount, dev);
        if (hipFuncSetAttribute((const void*)mk_fwd, hipFuncAttributeMaxDynamicSharedMemorySize, LDS_BYTES) != hipSuccess) { fprintf(stderr, "kernel_launch: hipFuncSetAttribute failed\n"); grid = -1; return; }
        if (hipOccupancyMaxActiveBlocksPerMultiprocessor(&per_cu, (const void*)mk_fwd, NTHREADS, LDS_BYTES) != hipSuccess || per_cu < 1) { fprintf(stderr, "kernel_launch: occupancy query says %d\n", per_cu); per_cu = 1; }
        (void)hipGetLastError();
        grid = cus * per_cu;
    }
    if (grid < 0) return;
    if (hipMemsetAsync((char*)d_ws + WS_BAR, 0, XCD_BAR_WORDS * 4, stream) != hipSuccess) { fprintf(stderr, "kernel_launch: memset of the barrier words failed\n"); return; }
    Args a{};
    for (int i = 0; i < 20; ++i) a.in[i] = (const float*)d_in[i];
    a.out = (float*)d_out; a.ws = (unsigned char*)d_ws; a.ph_lo = 0; a.ph_hi = N_PHASES;
    void* kargs[] = {&a};
    hipError_t e = hipLaunchCooperativeKernel((const void*)mk_fwd, dim3(grid), dim3(NTHREADS), kargs, LDS_BYTES, stream);
    if (e != hipSuccess) fprintf(stderr, "cooperative launch failed: %s (grid %d)\n", hipGetErrorString(e), grid);
}
```
